# Optimizing an MI355X kernel written in HIP

```python
import jax, jax.numpy as jnp
from jax import lax
import numpy as np

D_MODEL = 2048
BATCH = 2
SEQ = 4096
DEPTH = 1

HEAD_DIM = 128
MOBA_HEADS = 8
MOBA_BLOCK = 256
MOBA_TOPK = 3
DSA_HEADS = 8
IDX_HEADS = 16
IDX_DIM = 64
DSA_TOPK_MAX = 256
D_FF = 4 * D_MODEL
ROPE_THETA = 10000.0
Q_CHUNK = 32
RMS_EPS = 1e-6
MOBA_W = MOBA_HEADS * HEAD_DIM
DSA_W = DSA_HEADS * HEAD_DIM
IN_SIZES = (3 * MOBA_W, 3 * DSA_W, IDX_HEADS * IDX_DIM, IDX_DIM, IDX_HEADS, D_MODEL, D_MODEL)
D_IN = 3 * MOBA_W + 3 * DSA_W + IDX_HEADS * IDX_DIM + IDX_DIM + IDX_HEADS + 2 * D_MODEL

kernel_name = 'hybrid_moba_dsa_gated_block'


def _rmsnorm(x, g):
    xf = x.astype(jnp.float32)
    y = xf * lax.rsqrt(jnp.mean(xf * xf, axis=-1, keepdims=True) + RMS_EPS)
    return (y * g.astype(jnp.float32)).astype(x.dtype)


def _rope(x):
    T, dh = x.shape[1], x.shape[-1]
    half = dh // 2
    inv_freq = jnp.power(ROPE_THETA, -jnp.arange(half, dtype=jnp.float32) / half)
    ang = jnp.arange(T, dtype=jnp.float32)[:, None] * inv_freq[None, :]
    cos = jnp.cos(ang)[None, :, None, :]
    sin = jnp.sin(ang)[None, :, None, :]
    xf = x.astype(jnp.float32)
    x1, x2 = xf[..., :half], xf[..., half:]
    return jnp.concatenate([x1 * cos - x2 * sin, x2 * cos + x1 * sin], axis=-1).astype(x.dtype)


def _moba_attention(q, k, v):
    B, T, H, D = q.shape
    scale = D ** -0.5
    nb = -(-T // MOBA_BLOCK)
    pad = nb * MOBA_BLOCK - T
    kpad = jnp.pad(k, ((0, 0), (0, pad), (0, 0), (0, 0)))
    vpad = jnp.pad(v, ((0, 0), (0, pad), (0, 0), (0, 0)))
    kb = kpad.reshape(B, nb, MOBA_BLOCK, H, D)
    vb = vpad.reshape(B, nb, MOBA_BLOCK, H, D)
    k_mean = jnp.mean(kb.astype(jnp.float32), axis=2)
    gate = jnp.einsum('bthd,bnhd->bthn', q.astype(jnp.float32), k_mean)
    qblk = jnp.arange(T) // MOBA_BLOCK
    past = jnp.arange(nb)[None, :] < qblk[:, None]
    gate = jnp.where(past[None, :, None, :], gate, -jnp.inf)
    n_sel = max(1, min(MOBA_TOPK, nb - 1))
    _, sel_idx = lax.top_k(gate, n_sel)
    sel_ok = sel_idx < qblk[None, :, None, None]
    kbt = jnp.transpose(kb, (0, 3, 1, 2, 4))
    vbt = jnp.transpose(vb, (0, 3, 1, 2, 4))
    b_ix = jnp.arange(B)[:, None, None, None]
    h_ix = jnp.arange(H)[None, None, :, None]

    def chunk(start):
        qc = lax.dynamic_slice_in_dim(q, start, Q_CHUNK, axis=1)
        idx = lax.dynamic_slice_in_dim(sel_idx, start, Q_CHUNK, axis=1)
        ok = lax.dynamic_slice_in_dim(sel_ok, start, Q_CHUNK, axis=1)
        kg = kbt[b_ix, h_ix, idx]
        vg = vbt[b_ix, h_ix, idx]
        s_sel = jnp.einsum('bchd,bchsjd->bchsj', qc, kg).astype(jnp.float32) * scale
        s_sel = jnp.where(ok[..., None], s_sel, -jnp.inf).reshape(B, Q_CHUNK, H, n_sel * MOBA_BLOCK)
        blk_start = (start // MOBA_BLOCK) * MOBA_BLOCK
        ko = lax.dynamic_slice_in_dim(kpad, blk_start, MOBA_BLOCK, axis=1)
        vo = lax.dynamic_slice_in_dim(vpad, blk_start, MOBA_BLOCK, axis=1)
        s_own = jnp.einsum('bchd,bjhd->bchj', qc, ko).astype(jnp.float32) * scale
        qpos = start + jnp.arange(Q_CHUNK)
        kpos = blk_start + jnp.arange(MOBA_BLOCK)
        causal = kpos[None, :] <= qpos[:, None]
        s_own = jnp.where(causal[None, :, None, :], s_own, -jnp.inf)
        p = jax.nn.softmax(jnp.concatenate([s_sel, s_own], axis=-1), axis=-1).astype(v.dtype)
        p_sel = p[..., :n_sel * MOBA_BLOCK].reshape(B, Q_CHUNK, H, n_sel, MOBA_BLOCK)
        p_own = p[..., n_sel * MOBA_BLOCK:]
        return (jnp.einsum('bchsj,bchsjd->bchd', p_sel, vg)
                + jnp.einsum('bchj,bjhd->bchd', p_own, vo))

    starts = jnp.arange(T // Q_CHUNK, dtype=jnp.int32) * Q_CHUNK
    outs = lax.map(chunk, starts)
    return jnp.moveaxis(outs, 0, 1).reshape(B, T, H, D)


def _dsa_attention(q, k, v, q_idx, k_idx, w_idx):
    B, T, H, D = q.shape
    scale = D ** -0.5
    idx_scale = (IDX_DIM ** -0.5) * (IDX_HEADS ** -0.5)
    topk = min(DSA_TOPK_MAX, T // 4)
    kidx_f = k_idx.astype(jnp.float32)
    b_ix = jnp.arange(B)[:, None, None]

    def chunk(start):
        qc = lax.dynamic_slice_in_dim(q, start, Q_CHUNK, axis=1)
        qi = lax.dynamic_slice_in_dim(q_idx, start, Q_CHUNK, axis=1).astype(jnp.float32)
        wi = lax.dynamic_slice_in_dim(w_idx, start, Q_CHUNK, axis=1).astype(jnp.float32)
        rel = jax.nn.relu(jnp.einsum('bchi,bsi->bchs', qi, kidx_f))
        score = jnp.einsum('bch,bchs->bcs', wi, rel) * idx_scale
        qpos = start + jnp.arange(Q_CHUNK)
        admissible = jnp.arange(T)[None, :] <= qpos[:, None]
        score = jnp.where(admissible[None], score, -jnp.inf)
        _, idx = lax.top_k(score, topk)
        ok = idx <= qpos[None, :, None]
        kg = k[b_ix, idx]
        vg = v[b_ix, idx]
        s = jnp.einsum('bchd,bckhd->bchk', qc, kg).astype(jnp.float32) * scale
        s = jnp.where(ok[:, :, None, :], s, -jnp.inf)
        p = jax.nn.softmax(s, axis=-1).astype(v.dtype)
        return jnp.einsum('bchk,bckhd->bchd', p, vg)

    starts = jnp.arange(T // Q_CHUNK, dtype=jnp.int32) * Q_CHUNK
    outs = lax.map(chunk, starts)
    return jnp.moveaxis(outs, 0, 1).reshape(B, T, H, D)


def setup_inputs(seed: int = 0) -> dict:
    key = jax.random.key(seed)
    ks = jax.random.split(key, 16)
    f32 = jnp.float32

    def nrm(k, shape, fan_in, mult=1.0):
        return jax.random.normal(k, shape, f32) * (mult * fan_in ** -0.5)

    def gain(k):
        return 1.0 + 0.02 * jax.random.normal(k, (DEPTH, D_MODEL), f32)

    return {
        'x': jax.random.normal(ks[0], (BATCH, SEQ, D_MODEL), f32),
        'c': jax.random.normal(ks[1], (BATCH, D_MODEL), f32),
        'w_ada': nrm(ks[2], (DEPTH, D_MODEL, 6 * D_MODEL), D_MODEL),
        'b_ada': 0.02 * jax.random.normal(ks[3], (DEPTH, 6 * D_MODEL), f32),
        'g_pre_mix': gain(ks[4]),
        'g_post_mix': gain(ks[5]),
        'w_in': nrm(ks[6], (DEPTH, D_MODEL, D_IN), D_MODEL),
        'w_moba_out': nrm(ks[7], (DEPTH, MOBA_W, D_MODEL), MOBA_W),
        'w_dsa_out': nrm(ks[8], (DEPTH, DSA_W, D_MODEL), DSA_W),
        'w_o': nrm(ks[9], (DEPTH, D_MODEL, D_MODEL), D_MODEL),
        'g_pre_ffn': gain(ks[10]),
        'g_post_ffn': gain(ks[11]),
        'w_ff1': nrm(ks[12], (DEPTH, D_MODEL, D_FF), D_MODEL),
        'w_ff2': nrm(ks[13], (DEPTH, D_FF, D_MODEL), D_FF),
    }


def reference(x, c, w_ada, b_ada, g_pre_mix, g_post_mix, w_in, w_moba_out, w_dsa_out, w_o,
              g_pre_ffn, g_post_ffn, w_ff1, w_ff2):
    B, T, _ = x.shape
    cs = jax.nn.silu(c)
    split_pts = [int(v) for v in np.cumsum(IN_SIZES)[:-1]]
    for l in range(DEPTH):
        mod = cs @ w_ada[l] + b_ada[l]
        sh1, sc1, gt1, sh2, sc2, gt2 = [m[:, None, :] for m in jnp.split(mod, 6, axis=-1)]

        h = _rmsnorm(x, g_pre_mix[l]) * (1.0 + sc1) + sh1
        proj = h @ w_in[l]
        p_moba, p_dsa, p_qi, p_ki, p_wi, ga, gb = jnp.split(proj, split_pts, axis=-1)
        qa, ka, va = [t.reshape(B, T, MOBA_HEADS, HEAD_DIM) for t in jnp.split(p_moba, 3, axis=-1)]
        qb, kb, vb = [t.reshape(B, T, DSA_HEADS, HEAD_DIM) for t in jnp.split(p_dsa, 3, axis=-1)]
        q_idx = _rope(p_qi.reshape(B, T, IDX_HEADS, IDX_DIM))
        k_idx = _rope(p_ki[:, :, None, :])[:, :, 0, :]
        ya = _moba_attention(_rope(qa), _rope(ka), va).reshape(B, T, MOBA_W) @ w_moba_out[l]
        yb = _dsa_attention(_rope(qb), _rope(kb), vb, q_idx, k_idx, p_wi).reshape(B, T, DSA_W) @ w_dsa_out[l]
        y = (jax.nn.sigmoid(ga) * ya + jax.nn.sigmoid(gb) * yb) @ w_o[l]
        x = x + gt1 * _rmsnorm(y, g_post_mix[l])

        h = _rmsnorm(x, g_pre_ffn[l]) * (1.0 + sc2) + sh2
        f = jnp.square(jax.nn.relu(h @ w_ff1[l])) @ w_ff2[l]
        x = x + gt2 * _rmsnorm(f, g_post_ffn[l])
    return x
```

```cpp
#include <hip/hip_runtime.h>
#include <cstdio>
#include <cstdint>

#ifndef MK_N_LAUNCHES
#define MK_N_LAUNCHES 1
#endif

#ifndef MK_DOUBLE_MASK
#define MK_DOUBLE_MASK 0
#endif
#define LAS __attribute__((address_space(3)))
#define GAS __attribute__((address_space(1)))
typedef _Float16 f16;
typedef _Float16 f16x8 __attribute__((ext_vector_type(8)));
typedef _Float16 f16x4 __attribute__((ext_vector_type(4)));
typedef _Float16 f16x2 __attribute__((ext_vector_type(2)));
typedef float f32x2 __attribute__((ext_vector_type(2)));
typedef float f32x4 __attribute__((ext_vector_type(4)));
typedef float f32x16 __attribute__((ext_vector_type(16)));
typedef unsigned u32x2 __attribute__((ext_vector_type(2)));
typedef unsigned u32x4 __attribute__((ext_vector_type(4)));
typedef int i32x4 __attribute__((ext_vector_type(4)));
typedef int i32x8 __attribute__((ext_vector_type(8)));
typedef short s16x4 __attribute__((ext_vector_type(4)));
typedef unsigned long long u64;

constexpr int BATCH = 2, SEQ = 4096, DM = 2048, MTOK = BATCH * SEQ, NH = 8, HD = 128, AW = NH * HD, FF = 8192;
constexpr int IDXH = 16, IDXD = 64, DSA_TOPK = 256, MOBA_BLOCK = 256, MOBA_NB = SEQ / MOBA_BLOCK, MOBA_TOPK = 3;
constexpr int D_IN = 11344, N_IN_PAD = 11520;
constexpr int N_IN16 = 21 * 256, N_IN8 = 24 * 256;
constexpr int C_QI = 6144, C_KI = 7168, C_WI = 7232, C_GA = 7248, C_GB = 9296;
constexpr float RMS_EPS = 1e-6f;

constexpr size_t MiB = 1u << 20;
constexpr size_t WS_CTL = 0, CTL_ZERO_BYTES = 64 * 1024;
constexpr size_t WS_KMEAN = 1 * MiB;
constexpr size_t WS_MODF = 1 * MiB + 256 * 1024;
constexpr size_t WS_MODP = 2 * MiB;
constexpr size_t WS_SSP1 = 5 * MiB, WS_SSP2 = 6 * MiB;
constexpr size_t WS_ROPEA = 7 * MiB;
constexpr size_t WS_ROPEB = 9 * MiB;
constexpr size_t WS_WIDX = 10 * MiB;
constexpr size_t WS_KIDX = 10 * MiB + 512 * 1024;
constexpr size_t WS_MASK = 12 * MiB;
constexpr size_t WS_WIN = 16 * MiB;
constexpr size_t WS_WMO = 61 * MiB, WS_WDO = 65 * MiB, WS_WO = 69 * MiB, WS_W1 = 77 * MiB, WS_W2 = 109 * MiB;
constexpr size_t WS_H = 141 * MiB;
constexpr size_t WS_QKV = 173 * MiB;
constexpr size_t WS_QIDX = 269 * MiB;
constexpr size_t WS_GA = 285 * MiB, WS_GB = 317 * MiB;
constexpr size_t WS_U = 173 * MiB;
constexpr size_t WS_F = 301 * MiB;
constexpr size_t WS_H8 = 125 * MiB;
constexpr size_t WS_WG8 = 349 * MiB;
constexpr size_t WS_END = 361 * MiB;
constexpr size_t QKV_ONE = (size_t)MTOK * AW;

constexpr int NPHASE = 11;

__device__ __forceinline__ unsigned pkh(float lo, float hi) { f32x2 v = {lo, hi}; f16x2 h = __builtin_convertvector(v, f16x2); return __builtin_bit_cast(unsigned, h); }
__device__ __forceinline__ f32x2 unpkh(unsigned w) { f16x2 h = __builtin_bit_cast(f16x2, w); return __builtin_convertvector(h, f32x2); }
__device__ __forceinline__ float wave_sum(float v) {
#pragma unroll
    for (int o = 1; o < 64; o <<= 1) v += __shfl_xor(v, o);
    return v;
}
__device__ __forceinline__ float sigmoidf_(float x) { return __builtin_amdgcn_rcpf(1.0f + __builtin_amdgcn_exp2f(-1.4426950408889634f * x)); }
#define LDS_WAIT() asm volatile("s_waitcnt lgkmcnt(0)" ::: "memory")
#define VM_WAIT() asm volatile("s_waitcnt vmcnt(0)" ::: "memory")

namespace pg8 {
constexpr int BM = 256, BK = 64, HALF = 128, HTB = HALF * BK * 2, STAGE_BYTES = 8 * HTB, NXCD = 8, WGM = 8;
__host__ __device__ __forceinline__ int lds_byte(int r, int c) { const int st = (r >> 4) * 2 + (c >> 5), rr = r & 15, cc = c & 31, ob = rr * 64 + cc * 2; return st * 1024 + (ob ^ (((ob >> 9) & 1) << 5)); }
__host__ __device__ __forceinline__ void stage_rc(int b, int& R, int& C) { const int st = b / 1024, sb = b % 1024, swz = sb ^ (((sb >> 9) & 1) << 5); R = (st >> 1) * 16 + swz / 64; C = (st & 1) * 32 + (swz % 64) / 2; }
__host__ __device__ __forceinline__ int perm32(int rho) { const int n = rho >> 4, i = rho & 15; return 8 * (i >> 2) + 4 * n + (i & 3); }

struct Unit { int pm, pn, z; };
struct Gemm { const f16* A0; const f16* B0; const f16* A1; const f16* B1; int K; };

struct StaticOrder {
    int nM, nN, nwg, G, c, nz;
    __device__ void init(int M, int N, int G_, int c_, int nz_ = 1) { nM = M / BM; nN = N / BM; nwg = nM * nN; G = G_; c = c_; nz = nz_; }
    __device__ bool next(int i, Unit& u) const {
        const int it = i / nz; u.z = i - it * nz;
        const long L = (long)it * G + c; if (L >= nwg) return false;
        int wgid = (int)L; { const int q = nwg / NXCD, r = nwg % NXCD, xcd = wgid % NXCD, off = wgid / NXCD; wgid = (xcd < r ? xcd * (q + 1) : r * (q + 1) + (xcd - r) * q) + off; }
        const int nig = WGM * nN, gid = wgid / nig, fm = gid * WGM, gsz = (nM - fm) < WGM ? (nM - fm) : WGM;
        u.pm = fm + ((wgid % nig) % gsz); u.pn = (wgid % nig) / gsz; return true;
    }
};

template <class Epi, class Sched, bool ALIGN_EPI, bool F8 = false, int SCL_A = 0x7F7F7F7F, int SCL_B = 0x7F7F7F7F, bool ZI = false>
__device__ __forceinline__ void gemm_phase(LAS unsigned char* lds, const Gemm g, const Sched& S, const Epi& E) {
    const int tid = threadIdx.x, wid = __builtin_amdgcn_readfirstlane(tid >> 6), lane = tid & 63, wr = wid >> 2, wc = wid & 3, fr = lane & 15, fq = lane >> 4;
    const int K = g.K, Kb = F8 ? K : 2 * K  , nt = Kb / (2 * BK);
    unsigned voffA[2], voffB[2], voffB1[2];
#pragma unroll
    for (int i = 0; i < 2; ++i) { int R, C; stage_rc(tid * 16 + i * 8192, R, C); const int Rb = (R & ~31) + perm32(R & 31);
        voffA[i] = (unsigned)(R * Kb + C * 2);
        if constexpr (Epi::PERM256) { const int wq = R >> 5, n_ = (R >> 4) & 1, i_ = R & 15, r0 = 64 * wq + 16 * (i_ >> 2) + 4 * n_ + (i_ & 3);
            voffB[i] = (unsigned)(r0 * Kb + C * 2); voffB1[i] = (unsigned)((r0 + 8) * Kb + C * 2); }
        else { voffB[i] = (unsigned)(Rb * Kb + C * 2); voffB1[i] = voffB[i] + (unsigned)(HALF * Kb); } }
    const size_t kstep = (size_t)(BK * 2);
    const size_t hstep = (size_t)HALF * Kb;
    const size_t tstep = 2 * hstep;
    const unsigned ldsw = (unsigned)wid * 1024u;
    const int aoff = lds_byte(wr * 64 + fr, F8 ? fq * 16 : fq * 8), boff = lds_byte(wc * 32 + fr, F8 ? fq * 16 : fq * 8);
#define PG8_SA(b, h) (((b) * 2 + (h)) * HTB)
#define PG8_SB(b, h) ((4 + (b) * 2 + (h)) * HTB)
#define PG8_STAGE(bufoff, gbase, voff) do { _Pragma("unroll") for (int _i = 0; _i < 2; ++_i) \
        __builtin_amdgcn_global_load_lds((const unsigned*)((const char*)(gbase) + (voff)[_i]), (LAS unsigned*)(lds + (bufoff) + ldsw + _i * 8192), 16, 0, 0); } while (0)
#define PG8_KOFF(k) (F8 ? (k) * 16 : (k) * 1024)
#define PG8_LDA(dst, b, h) do { _Pragma("unroll") for (int m = 0; m < 4; ++m) _Pragma("unroll") for (int k = 0; k < 2; ++k) dst[m][k] = *(const LAS f16x8*)(lds + PG8_SA(b, h) + aoff + m * 2048 + PG8_KOFF(k)); } while (0)
#define PG8_LDB(dst, b, h) do { _Pragma("unroll") for (int n = 0; n < 2; ++n) _Pragma("unroll") for (int k = 0; k < 2; ++k) dst[n][k] = *(const LAS f16x8*)(lds + PG8_SB(b, h) + boff + n * 2048 + PG8_KOFF(k)); } while (0)
#define PG8_F8(x) __builtin_shufflevector(__builtin_bit_cast(i32x4, x[0]), __builtin_bit_cast(i32x4, x[1]), 0, 1, 2, 3, 4, 5, 6, 7)
      \
#define PG8_MMA(ai, bj, At, Bt, Z) do { __builtin_amdgcn_s_setprio(1); _Pragma("unroll") for (int m = 0; m < 4; ++m) _Pragma("unroll") for (int n = 0; n < 2; ++n) { \
        if constexpr (F8) { const i32x8 b8_ = PG8_F8(Bt[n]), a8_ = PG8_F8(At[m]);     \
            if constexpr (Z) asm volatile("v_mfma_scale_f32_16x16x128_f8f6f4 %0, %1, %2, 0, %3, %4 op_sel_hi:[0,0,0]" : "=&v"(acc[ai][bj][m][n]) : "v"(b8_), "v"(a8_), "v"(sclB_), "v"(sclA_)); \
            else asm volatile("v_mfma_scale_f32_16x16x128_f8f6f4 %0, %1, %2, %0, %3, %4 op_sel_hi:[0,0,0]" : "+v"(acc[ai][bj][m][n]) : "v"(b8_), "v"(a8_), "v"(sclB_), "v"(sclA_)); } \
        else { if constexpr (Z) acc[ai][bj][m][n] = __builtin_amdgcn_mfma_f32_16x16x32_f16(Bt[n][0], At[m][0], (f32x4){0.f, 0.f, 0.f, 0.f}, 0, 0, 0); \
               else acc[ai][bj][m][n] = __builtin_amdgcn_mfma_f32_16x16x32_f16(Bt[n][0], At[m][0], acc[ai][bj][m][n], 0, 0, 0); \
               acc[ai][bj][m][n] = __builtin_amdgcn_mfma_f32_16x16x32_f16(Bt[n][1], At[m][1], acc[ai][bj][m][n], 0, 0, 0); } } \
        __builtin_amdgcn_s_setprio(0); } while (0)
#define PG8_WAIT_V(n) asm volatile("s_waitcnt vmcnt(" #n ")" ::: "memory")
#define PG8_WAIT_L(n) asm volatile("s_waitcnt lgkmcnt(" #n ")" ::: "memory")
#define PG8_BAR __builtin_amdgcn_s_barrier()
#define PG8_SCHED __builtin_amdgcn_sched_barrier(0)
    constexpr bool ZINIT = ZI && !Epi::KEEPS;
    Unit cur, nxt; int ui = 0;
    if (!S.next(0, cur)) return;
    f32x4 acc[2][2][4][2];
#pragma unroll
    for (int a = 0; a < 2; ++a)
#pragma unroll
        for (int b = 0; b < 2; ++b)
#pragma unroll
            for (int m = 0; m < 4; ++m)
#pragma unroll
                for (int n = 0; n < 2; ++n) acc[a][b][m][n] = (f32x4){0.f, 0.f, 0.f, 0.f};
    f16x8 At[4][2], B0[2][2], B1[2][2];
    const int sclA_ = SCL_A, sclB_ = SCL_B; (void)sclA_; (void)sclB_;
    const char* cA = (const char*)(cur.z ? g.A1 : g.A0) + (size_t)cur.pm * tstep; const char* cB = (const char*)(cur.z ? g.B1 : g.B0) + (size_t)cur.pn * tstep;
    PG8_STAGE(PG8_SB(0, 0), cB, voffB); PG8_STAGE(PG8_SB(0, 1), cB, voffB1); PG8_STAGE(PG8_SA(0, 0), cA, voffA); PG8_STAGE(PG8_SA(0, 1), cA + hstep, voffA);
    if (wr == 1) PG8_BAR;
    PG8_WAIT_V(2); PG8_BAR;
    PG8_STAGE(PG8_SB(1, 0), cB + kstep, voffB); PG8_STAGE(PG8_SA(1, 0), cA + kstep, voffA); PG8_STAGE(PG8_SB(1, 1), cB + kstep, voffB1);
    PG8_WAIT_V(6); PG8_BAR;
    for (;;) {
        const bool has_next = S.next(ui + 1, nxt);
        const char* nA = has_next ? (const char*)(nxt.z ? g.A1 : g.A0) + (size_t)nxt.pm * tstep : cA; const char* nB = has_next ? (const char*)(nxt.z ? g.B1 : g.B0) + (size_t)nxt.pn * tstep : cB;
#define PG8_BODY(Z) do { \
            const bool last = (t == nt - 2); \
            const char* a1 = cA + (size_t)(t + 1) * kstep; \
            const char* a2 = last ? nA : cA + (size_t)(t + 2) * kstep; const char* b2 = last ? nB : cB + (size_t)(t + 2) * kstep; \
            const char* a3 = a2 + kstep; const char* b3 = b2 + kstep; \
            PG8_LDB(B0, 0, 0); PG8_LDB(B1, 0, 1); PG8_SCHED; PG8_LDA(At, 0, 0); PG8_STAGE(PG8_SA(1, 1), a1 + hstep, voffA); \
            PG8_WAIT_V(8); PG8_WAIT_L(0); PG8_BAR; PG8_MMA(0, 0, At, B0, Z); PG8_MMA(0, 1, At, B1, Z); PG8_BAR; PG8_SCHED; \
            PG8_LDA(At, 0, 1); PG8_STAGE(PG8_SB(0, 0), b2, voffB); PG8_STAGE(PG8_SB(0, 1), b2, voffB1); PG8_STAGE(PG8_SA(0, 0), a2, voffA); \
            PG8_WAIT_V(8); PG8_WAIT_L(0); PG8_BAR; PG8_MMA(1, 0, At, B0, Z); PG8_MMA(1, 1, At, B1, Z); PG8_BAR; PG8_SCHED; \
            PG8_LDB(B0, 1, 0); PG8_LDB(B1, 1, 1); PG8_SCHED; PG8_LDA(At, 1, 0); PG8_STAGE(PG8_SA(0, 1), a2 + hstep, voffA); \
            PG8_WAIT_V(8); PG8_WAIT_L(0); PG8_BAR; PG8_MMA(0, 0, At, B0, false); PG8_MMA(0, 1, At, B1, false); PG8_BAR; PG8_SCHED; \
            PG8_LDA(At, 1, 1); PG8_STAGE(PG8_SB(1, 0), b3, voffB); PG8_STAGE(PG8_SB(1, 1), b3, voffB1); PG8_STAGE(PG8_SA(1, 0), a3, voffA); \
            PG8_WAIT_V(8); PG8_WAIT_L(0); PG8_BAR; PG8_MMA(1, 0, At, B0, false); PG8_MMA(1, 1, At, B1, false); PG8_BAR; PG8_SCHED; } while (0)
        if constexpr (ZINIT) { { const int t = 0; PG8_BODY(true); }
            for (int t = 2; t < nt; t += 2) PG8_BODY(false); }
        else { for (int t = 0; t < nt; t += 2) PG8_BODY(false); }
        if constexpr (ALIGN_EPI) { if (wr == 0) PG8_BAR; }
        if constexpr (F8) asm volatile("s_nop 15\n\ts_nop 15" ::: "memory");
        { int t2 = threadIdx.x; asm volatile("" : "+v"(t2));
          const int w2 = __builtin_amdgcn_readfirstlane(t2 >> 6), l2 = t2 & 63; E(acc, cur, w2 >> 2, w2 & 3, l2 & 15, l2 >> 4); }
        if (!has_next) break;
        if (!ZINIT && !E.keep(cur)) {
#pragma unroll
        for (int a = 0; a < 2; ++a)
#pragma unroll
            for (int b = 0; b < 2; ++b)
#pragma unroll
                for (int m = 0; m < 4; ++m)
#pragma unroll
                    for (int n = 0; n < 2; ++n) acc[a][b][m][n] = (f32x4){0.f, 0.f, 0.f, 0.f};
        }
        cur = nxt; cA = nA; cB = nB; ++ui;
        if constexpr (ALIGN_EPI) { if (wr == 1) PG8_BAR; }
    }
    PG8_WAIT_V(0);
    if constexpr (!ALIGN_EPI) { if (wr == 0) PG8_BAR; }
    PG8_BAR;
#undef PG8_SA
#undef PG8_SB
#undef PG8_STAGE
#undef PG8_LDA
#undef PG8_LDB
#undef PG8_MMA
#undef PG8_BODY
#undef PG8_F8
#undef PG8_KOFF
#undef PG8_WAIT_V
#undef PG8_WAIT_L
#undef PG8_BAR
#undef PG8_SCHED
}

typedef f32x4 AccT[2][2][4][2];
__device__ __forceinline__ void st8h(f16* p, const f32x4& a, const f32x4& b) { u32x4 w; w.x = pkh(a[0], a[1]); w.y = pkh(a[2], a[3]); w.z = pkh(b[0], b[1]); w.w = pkh(b[2], b[3]); *(u32x4*)p = w; }

struct EpiIn {
    static constexpr bool PERM256 = false, KEEPS = false;
    f16* qkv; f16* qidx; f16* kidx; float* widx; f16* ga; f16* gb; const float* ropeA; const float* ropeB; int mode;
    __device__ __forceinline__ bool keep(const Unit&) const { return false; }
    static __device__ __forceinline__ void rope8(const f32x4& a0, const f32x4& a1, const f32x4& b0, const f32x4& b1, const f32x4& c0, const f32x4& c1, const f32x4& c2, const f32x4& c3, f16* dlo, f16* dhi) {
        const f32x4 o1a = a0 * c0 - b0 * c1, o2a = b0 * c0 + a0 * c1, o1b = a1 * c2 - b1 * c3, o2b = b1 * c2 + a1 * c3;
        st8h(dlo, o1a, o1b); st8h(dhi, o2a, o2b);
    }
    template <class F>
    static __device__ __forceinline__ void rope_tile(AccT& acc, int row0, const float* tab, int tw, int dlo, int hoff, F dstf) {
        f32x4 cs[2][2][4];
#define ROPE_LD(q_, buf_) do { _Pragma("unroll") for (int mm = 0; mm < 2; ++mm) { const int t = (row0 + ((q_) >> 1) * HALF + (((q_) & 1) * 2 + mm) * 16) & (SEQ - 1); const float* cp = tab + ((size_t)t * tw + dlo) * 2; \
            _Pragma("unroll") for (int i = 0; i < 4; ++i) cs[buf_][mm][i] = *(const f32x4*)(cp + 4 * i); } } while (0)
#define ROPE_DO(q_, buf_) do { _Pragma("unroll") for (int mm = 0; mm < 2; ++mm) { const int ai = (q_) >> 1, m = ((q_) & 1) * 2 + mm; f16* dst = dstf(row0 + ai * HALF + m * 16); \
            rope8(acc[ai][0][m][0], acc[ai][0][m][1], acc[ai][1][m][0], acc[ai][1][m][1], cs[buf_][mm][0], cs[buf_][mm][1], cs[buf_][mm][2], cs[buf_][mm][3], dst, dst + hoff); } } while (0)
        ROPE_LD(0, 0); ROPE_LD(1, 1); ROPE_DO(0, 0); ROPE_LD(2, 0); ROPE_DO(1, 1); ROPE_LD(3, 1); ROPE_DO(2, 0); ROPE_DO(3, 1);
#undef ROPE_LD
#undef ROPE_DO
    }
    __device__ __forceinline__ void operator()(AccT& acc, const Unit& u, int wr, int wc, int fr, int fq) const {
        const int p_ = u.pn; const int pn = mode == 0 ? (p_ < 8 ? p_ : (p_ < 16 ? p_ + 4 : p_ + 8)) : (p_ < 4 ? 8 + p_ : (p_ < 8 ? 16 + p_ : 21 + p_));
        const int row0 = u.pm * BM + wr * 64 + fr;
        if (pn < 24) {
            const int kind6 = pn >> 2, hp = pn & 3; f16* base = qkv + (size_t)kind6 * QKV_ONE;
            if ((kind6 % 3) != 2) {
                const int head = 2 * hp + (wc >> 1), dlo = 32 * (wc & 1) + 8 * fq;
                rope_tile(acc, row0, ropeA, 64, dlo, 64, [&](int row) { const int b = row >> 12, t = row & (SEQ - 1); return base + ((size_t)(b * NH + head) * SEQ + t) * HD + dlo; });
            } else {
#pragma unroll
                for (int ai = 0; ai < 2; ++ai)
#pragma unroll
                    for (int m = 0; m < 4; ++m) { const int row = row0 + ai * HALF + m * 16, b = row >> 12, t = row & (SEQ - 1);
#pragma unroll
                        for (int bj = 0; bj < 2; ++bj) { f16* dst = base + ((size_t)(b * NH + 2 * hp + bj) * SEQ + t) * HD + 32 * wc + 8 * fq; st8h(dst, acc[ai][bj][m][0], acc[ai][bj][m][1]); } }
            }
        } else if (pn < 28) {
            const int head = 4 * (pn - 24) + wc, dlo = 8 * fq;
            rope_tile(acc, row0, ropeB, 32, dlo, 32, [&](int row) { return qidx + (size_t)row * (IDXH * IDXD) + head * IDXD + dlo; });
        } else if (pn == 28) {
            if (wc == 0) {
                const int dlo = 8 * fq;
                rope_tile(acc, row0, ropeB, 32, dlo, 32, [&](int row) { return kidx + (size_t)row * IDXD + dlo; });
            } else if (wc == 1 && fq < 2) {
#pragma unroll
                for (int ai = 0; ai < 2; ++ai)
#pragma unroll
                    for (int m = 0; m < 4; ++m) { const int row = row0 + ai * HALF + m * 16; float* dst = widx + (size_t)row * IDXH + 8 * fq;
                        *(f32x4*)dst = acc[ai][0][m][0]; *(f32x4*)(dst + 4) = acc[ai][0][m][1]; }
            }
        } else {
            f16* gp = pn < 37 ? ga : gb; const int ct = (pn < 37 ? pn - 29 : pn - 37) * BM + 32 * wc + 8 * fq;
#pragma unroll
            for (int ai = 0; ai < 2; ++ai)
#pragma unroll
                for (int m = 0; m < 4; ++m) { const int row = row0 + ai * HALF + m * 16;
#pragma unroll
                    for (int bj = 0; bj < 2; ++bj) { f32x4 a = acc[ai][bj][m][0], b = acc[ai][bj][m][1];
#pragma unroll
                        for (int e = 0; e < 4; ++e) { a[e] = sigmoidf_(a[e]); b[e] = sigmoidf_(b[e]); }
                        st8h(gp + (size_t)row * DM + ct + bj * HALF, a, b); } }
        }
    }
};
struct EpiOut {
    static constexpr bool PERM256 = true, KEEPS = true;
    const f16* ga; const f16* gb; unsigned char* y;
    __device__ __forceinline__ bool keep(const Unit& u) const { return u.z == 0; }
    __device__ __forceinline__ void operator()(AccT& acc, const Unit& u, int wr, int wc, int fr, int fq) const {
        const int row0 = u.pm * BM + wr * 64 + fr, col0 = u.pn * BM + 64 * wc + 16 * fq;
        u32x4 wbv[2][2][2], wav[2][2][2];
#define EO_LD(q_, buf_) do { _Pragma("unroll") for (int mm = 0; mm < 2; ++mm) _Pragma("unroll") for (int bj = 0; bj < 2; ++bj) { \
            const size_t off = (size_t)(row0 + ((q_) >> 1) * HALF + (((q_) & 1) * 2 + mm) * 16) * DM + col0 + bj * 8; \
            wbv[buf_][mm][bj] = *(const u32x4*)(gb + off); if (u.z == 0) wav[buf_][mm][bj] = *(const u32x4*)(ga + off); } } while (0)
#define EO_DO(q_, buf_) do { _Pragma("unroll") for (int mm = 0; mm < 2; ++mm) { const int ai = (q_) >> 1, m = ((q_) & 1) * 2 + mm; \
            const size_t off = (size_t)(row0 + ai * HALF + m * 16) * DM + col0; u32x4 ow; \
            _Pragma("unroll") for (int bj = 0; bj < 2; ++bj) { \
                const u32x4 wb = wbv[buf_][mm][bj]; \
                const f32x2 b0 = unpkh(wb.x), b1 = unpkh(wb.y), b2 = unpkh(wb.z), b3 = unpkh(wb.w); \
                if (u.z == 0) { \
                    const u32x4 wa = wav[buf_][mm][bj]; \
                    const f32x2 a0 = unpkh(wa.x), a1 = unpkh(wa.y), a2 = unpkh(wa.z), a3 = unpkh(wa.w); \
                    f32x4& x = acc[ai][bj][m][0]; f32x4& w = acc[ai][bj][m][1]; \
                    x[0] *= a0.x * __builtin_amdgcn_rcpf(b0.x); x[1] *= a0.y * __builtin_amdgcn_rcpf(b0.y); x[2] *= a1.x * __builtin_amdgcn_rcpf(b1.x); x[3] *= a1.y * __builtin_amdgcn_rcpf(b1.y); \
                    w[0] *= a2.x * __builtin_amdgcn_rcpf(b2.x); w[1] *= a2.y * __builtin_amdgcn_rcpf(b2.y); w[2] *= a3.x * __builtin_amdgcn_rcpf(b3.x); w[3] *= a3.y * __builtin_amdgcn_rcpf(b3.y); \
                } else { \
                    f32x4 x = acc[ai][bj][m][0], w = acc[ai][bj][m][1]; \
                    x[0] *= b0.x; x[1] *= b0.y; x[2] *= b1.x; x[3] *= b1.y; w[0] *= b2.x; w[1] *= b2.y; w[2] *= b3.x; w[3] *= b3.y; \
                    _Pragma("unroll") for (int e = 0; e < 4; ++e) { x[e] = __builtin_amdgcn_fmed3f(x[e] * 16.f, -448.f, 448.f); w[e] = __builtin_amdgcn_fmed3f(w[e] * 16.f, -448.f, 448.f); } \
                    int w0 = 0, w1 = 0; \
                    w0 = __builtin_amdgcn_cvt_pk_fp8_f32(x[0], x[1], w0, false); w0 = __builtin_amdgcn_cvt_pk_fp8_f32(x[2], x[3], w0, true); \
                    w1 = __builtin_amdgcn_cvt_pk_fp8_f32(w[0], w[1], w1, false); w1 = __builtin_amdgcn_cvt_pk_fp8_f32(w[2], w[3], w1, true); \
                    if (bj == 0) { ow.x = (unsigned)w0; ow.y = (unsigned)w1; } else { ow.z = (unsigned)w0; ow.w = (unsigned)w1; } \
                } \
            } \
            if (u.z != 0) *(u32x4*)(y + off) = ow; } } while (0)
        EO_LD(0, 0); EO_LD(1, 1); EO_DO(0, 0); EO_LD(2, 0); EO_DO(1, 1); EO_LD(3, 1); EO_DO(2, 0); EO_DO(3, 1);
#undef EO_LD
#undef EO_DO
    }
};
struct EpiSq {
    static constexpr bool PERM256 = false, KEEPS = false;
    f16* out; float* ssp;
    __device__ __forceinline__ bool keep(const Unit&) const { return false; }
    __device__ __forceinline__ void operator()(AccT& acc, const Unit& u, int wr, int wc, int fr, int fq) const {
        const int row0 = u.pm * BM + wr * 64 + fr, col0 = u.pn * BM + 32 * wc + 8 * fq;
#pragma unroll
        for (int ai = 0; ai < 2; ++ai)
#pragma unroll
            for (int m = 0; m < 4; ++m) { const int row = row0 + ai * HALF + m * 16; float s = 0.f;
#pragma unroll
                for (int bj = 0; bj < 2; ++bj) { const f32x4 a = acc[ai][bj][m][0], b = acc[ai][bj][m][1];
                    s += (a[0] * a[0] + a[1] * a[1]) + (a[2] * a[2] + a[3] * a[3]) + (b[0] * b[0] + b[1] * b[1]) + (b[2] * b[2] + b[3] * b[3]);
                    st8h(out + (size_t)row * DM + col0 + bj * HALF, a, b); }
                s += __shfl_xor(s, 16); s += __shfl_xor(s, 32);
                if (fq == 0) ssp[(size_t)row * 32 + u.pn * 4 + wc] = s; }
    }
};
struct EpiRelu2 {
    static constexpr bool PERM256 = true, KEEPS = false;
    unsigned char* out;
    __device__ __forceinline__ bool keep(const Unit&) const { return false; }
    __device__ __forceinline__ void operator()(AccT& acc, const Unit& u, int wr, int wc, int fr, int fq) const {
        const int row0 = u.pm * BM + wr * 64 + fr, col0 = u.pn * BM + 64 * wc + 16 * fq;
#pragma unroll
        for (int ai = 0; ai < 2; ++ai)
#pragma unroll
            for (int m = 0; m < 4; ++m) { const int row = row0 + ai * HALF + m * 16; u32x4 ow;
#pragma unroll
                for (int bj = 0; bj < 2; ++bj) { f32x4 a = acc[ai][bj][m][0], b = acc[ai][bj][m][1];
#pragma unroll
                    for (int e = 0; e < 4; ++e) { const float x = __builtin_amdgcn_fmed3f(a[e], 0.f, 21.16601f), y = __builtin_amdgcn_fmed3f(b[e], 0.f, 21.16601f); a[e] = x * x; b[e] = y * y; }
                    int w0 = 0, w1 = 0;
                    w0 = __builtin_amdgcn_cvt_pk_fp8_f32(a[0], a[1], w0, false); w0 = __builtin_amdgcn_cvt_pk_fp8_f32(a[2], a[3], w0, true);
                    w1 = __builtin_amdgcn_cvt_pk_fp8_f32(b[0], b[1], w1, false); w1 = __builtin_amdgcn_cvt_pk_fp8_f32(b[2], b[3], w1, true);
                    if (bj == 0) { ow.x = (unsigned)w0; ow.y = (unsigned)w1; } else { ow.z = (unsigned)w0; ow.w = (unsigned)w1; } }
                *(u32x4*)(out + (size_t)row * FF + col0) = ow; }
    }
};
}

namespace att {
constexpr int D = 128, NW = 8, QBLK = 32, KVBLK = 64, QB = NW * QBLK;
constexpr int SHM_V = KVBLK * D * 2, SHM_K = KVBLK * D * 2;
constexpr int LDS_SELM = 2 * SHM_V + 2 * SHM_K + NW * 64 * 4;
constexpr int LDS_KM = LDS_SELM + 2 * 256 * 4;
constexpr int LDS_Q = 79872;
constexpr float SCALE = 0.08838834764831845f, THR = 8.f;
#define KSWZ(row, colB) ((row) * 256 + ((colB) ^ (((row) & 7) << 4)))
#define SBAR() __builtin_amdgcn_sched_barrier(0)
__device__ __forceinline__ int v_st(int k, int c) { const int kk = (k & ~0xC) | ((k & 4) << 1) | ((k & 8) >> 1); return ((kk >> 3) * 4 + (c >> 5)) * 512 + ((kk & 7) * 32 + (c & 31)) * 2; }
__device__ __forceinline__ int v_rd_base(int lane) { return ((lane & 3) << 3) | (((lane >> 2) & 3) << 6) | (((lane >> 4) & 1) << 5) | (((lane >> 5) & 1) << 8); }
constexpr int v_rd_off(int d0, int ks, int half) { return d0 * 512 + ks * 4096 + half * 2048; }
__device__ __forceinline__ int crow(int r, int hi) { return (r & 3) + 8 * (r >> 2) + 4 * hi; }
__device__ __forceinline__ f16x8 load8(const f16* p) { return *reinterpret_cast<const f16x8*>(p); }
__device__ __forceinline__ void mask_causal(f32x16& p0, f32x16& p1, int dq) {
    const float NEG = -__builtin_inff();
#pragma unroll
    for (int r = 0; r < 16; ++r) { const int c = (r & 3) + 8 * (r >> 2); if (dq - c < 0) p0[r] = NEG; if (dq - c - 32 < 0) p1[r] = NEG; }
}
__device__ __forceinline__ void mask_bits(f32x16& p0, f32x16& p1, unsigned w0, unsigned w1) {
#pragma unroll
    for (int r = 0; r < 16; ++r) { const int c = (r & 3) + 8 * (r >> 2);
        const unsigned m0 = (unsigned)__builtin_amdgcn_sbfe((int)w0, c, 1), m1 = (unsigned)__builtin_amdgcn_sbfe((int)w1, c, 1);
        p0[r] = __uint_as_float((__float_as_uint(p0[r]) & m0) | (~m0 & 0xFF800000u));
        p1[r] = __uint_as_float((__float_as_uint(p1[r]) & m1) | (~m1 & 0xFF800000u)); }
}
__device__ __forceinline__ float sm_max(const f32x16& p0, const f32x16& p1) {
    float pmax, pmb;
    asm("v_max3_f32 %0, %1, %2, %3" : "=v"(pmax) : "v"(p0[0]), "v"(p0[1]), "v"(p0[2])); asm("v_max3_f32 %0, %1, %2, %3" : "=v"(pmb) : "v"(p1[0]), "v"(p1[1]), "v"(p1[2]));
#pragma unroll
    for (int r = 3; r < 15; r += 2) { asm("v_max3_f32 %0, %0, %1, %2" : "+v"(pmax) : "v"(p0[r]), "v"(p0[r + 1])); asm("v_max3_f32 %0, %0, %1, %2" : "+v"(pmb) : "v"(p1[r]), "v"(p1[r + 1])); }
    asm("v_max3_f32 %0, %0, %1, %2" : "+v"(pmax) : "v"(p0[15]), "v"(p1[15])); asm("v_max_f32 %0, %0, %1" : "+v"(pmax) : "v"(pmb));
    { auto rr = __builtin_amdgcn_permlane32_swap(__float_as_uint(pmax), __float_as_uint(pmax), false, false);
      float a_ = __uint_as_float(rr[0]), b_ = __uint_as_float(rr[1]); asm("v_max_f32 %0, %1, %2" : "=v"(pmax) : "v"(a_), "v"(b_)); }
    return pmax;
}
__device__ __forceinline__ float sm_decide(float pmax, float& m_reg, float& mn, float& alpha) {
    constexpr float C2 = 1.4426950408889634f * SCALE;
    if (__builtin_expect(__all((pmax - m_reg) * SCALE <= THR), 1)) { mn = m_reg; alpha = 1.f; }
    else { mn = fmaxf(m_reg, pmax); alpha = __builtin_amdgcn_exp2f((m_reg - mn) * C2); m_reg = mn; }
    return -mn * C2;
}
__device__ __forceinline__ void sm_fma(f32x16& p, float mnL) { constexpr float C2 = 1.4426950408889634f * SCALE; for (int r = 0; r < 16; ++r) p[r] = fmaf(p[r], C2, mnL); }
__device__ __forceinline__ void sm_exp(f32x16& p) { for (int r = 0; r < 16; ++r) p[r] = __builtin_amdgcn_exp2f(p[r]); }
__device__ __forceinline__ void partialSM(f32x16& p0, f32x16& p1, float& m_reg, float& mn, float& alpha) {
    const float pmax = sm_max(p0, p1); const float mnL = sm_decide(pmax, m_reg, mn, alpha); sm_fma(p0, mnL); sm_fma(p1, mnL); sm_exp(p0);
}
__device__ __forceinline__ void finishSM(f32x16& p0, f32x16& p1, float alpha, float& l_reg, f16x8& pa0, f16x8& pa1, f16x8& pa2, f16x8& pa3) {
    for (int r = 0; r < 16; ++r) p1[r] = __builtin_amdgcn_exp2f(p1[r]);
    float ps = 0; for (int r = 0; r < 16; ++r) ps += p0[r]; for (int r = 0; r < 16; ++r) ps += p1[r];
    { auto rr = __builtin_amdgcn_permlane32_swap(__float_as_uint(ps), __float_as_uint(ps), false, false);
      ps = __uint_as_float(rr[0]) + __uint_as_float(rr[1]); }
    l_reg = l_reg * alpha + ps;
#define PK4(P, B_, OUT) do { unsigned a0 = pkh(P[B_+0], P[B_+1]), a1 = pkh(P[B_+2], P[B_+3]);                          \
        unsigned b0 = pkh(P[B_+4], P[B_+5]), b1 = pkh(P[B_+6], P[B_+7]);                                             \
        auto r0 = __builtin_amdgcn_permlane32_swap(a0, b0, false, false); auto r1 = __builtin_amdgcn_permlane32_swap(a1, b1, false, false); \
        u32x4 w = {r0[0], r1[0], r0[1], r1[1]}; OUT = *reinterpret_cast<f16x8*>(&w); } while (0)
    PK4(p0, 0, pa0); PK4(p0, 8, pa1); PK4(p1, 0, pa2); PK4(p1, 8, pa3);
#undef PK4
}
#define ATT_TRRD(dst, off) asm volatile("ds_read_b64_tr_b16 %0, %1 offset:%2" : "=&v"(dst) : "v"(vb0), "i"(off) : "memory")
#define ATT_MKV(l, h) __builtin_bit_cast(f16x8, (__attribute__((ext_vector_type(8))) short){l[0], l[1], l[2], l[3], h[0], h[1], h[2], h[3]})
#define ATT_PVG(VB, d0) do { s16x4 l0, l1, l2, l3, h0, h1, h2, h3; constexpr int b_ = (VB) * SHM_V + v_rd_off(d0, 0, 0); \
        ATT_TRRD(l0, b_); ATT_TRRD(h0, b_ + 2048); ATT_TRRD(l1, b_ + 4096); ATT_TRRD(h1, b_ + 6144); ATT_TRRD(l2, b_ + 8192); ATT_TRRD(h2, b_ + 10240); ATT_TRRD(l3, b_ + 12288); ATT_TRRD(h3, b_ + 14336); \
        asm volatile("s_waitcnt lgkmcnt(0)" ::: "memory"); SBAR();   \
        o[d0] = __builtin_amdgcn_mfma_f32_32x32x16_f16(pa0, ATT_MKV(l0, h0), o[d0], 0, 0, 0);   \
        o[d0] = __builtin_amdgcn_mfma_f32_32x32x16_f16(pa1, ATT_MKV(l1, h1), o[d0], 0, 0, 0);   \
        o[d0] = __builtin_amdgcn_mfma_f32_32x32x16_f16(pa2, ATT_MKV(l2, h2), o[d0], 0, 0, 0);   \
        o[d0] = __builtin_amdgcn_mfma_f32_32x32x16_f16(pa3, ATT_MKV(l3, h3), o[d0], 0, 0, 0); SBAR(); } while (0)
template <int VB>
__device__ __forceinline__ void pv_tile(f32x16* o, int vb0, f16x8 pa0, f16x8 pa1, f16x8 pa2, f16x8 pa3) {
#define TRRD(dst, off) asm volatile("ds_read_b64_tr_b16 %0, %1 offset:%2" : "=&v"(dst) : "v"(vb0), "i"(off) : "memory")
#define MKV(l, h) __builtin_bit_cast(f16x8, (__attribute__((ext_vector_type(8))) short){l[0], l[1], l[2], l[3], h[0], h[1], h[2], h[3]})
#define PV_D0(d0) do { s16x4 l0, l1, l2, l3, h0, h1, h2, h3; constexpr int b_ = VB * SHM_V + v_rd_off(d0, 0, 0); \
        TRRD(l0, b_); TRRD(h0, b_ + 2048); TRRD(l1, b_ + 4096); TRRD(h1, b_ + 6144); TRRD(l2, b_ + 8192); TRRD(h2, b_ + 10240); TRRD(l3, b_ + 12288); TRRD(h3, b_ + 14336); \
        asm volatile("s_waitcnt lgkmcnt(0)" ::: "memory"); SBAR();   \
        o[d0] = __builtin_amdgcn_mfma_f32_32x32x16_f16(pa0, MKV(l0, h0), o[d0], 0, 0, 0);   \
        o[d0] = __builtin_amdgcn_mfma_f32_32x32x16_f16(pa1, MKV(l1, h1), o[d0], 0, 0, 0);   \
        o[d0] = __builtin_amdgcn_mfma_f32_32x32x16_f16(pa2, MKV(l2, h2), o[d0], 0, 0, 0);   \
        o[d0] = __builtin_amdgcn_mfma_f32_32x32x16_f16(pa3, MKV(l3, h3), o[d0], 0, 0, 0); } while (0)
    PV_D0(0); PV_D0(1); PV_D0(2); PV_D0(3);
#undef PV_D0
#undef MKV
#undef TRRD
}
struct BlockRef { const f16* Q; const f16* K; const f16* V; f16* O; int P0; const u64* M; const unsigned* sel; };
#define ROW(p, k0, rr) ((p) + (size_t)((k0) + (rr)) * D + sc)
#define VMW() asm volatile("s_waitcnt vmcnt(0)" ::: "memory")
#define SLOAD_H(Kp, Vp, k0) do { st_v0 = load8(ROW(Vp, k0, sr)); st_v1 = load8(ROW(Vp, k0, 32 + sr));              \
                         st_k0 = load8(ROW(Kp, k0, sr)); st_k1 = load8(ROW(Kp, k0, 32 + sr)); } while (0)
#define SWRITE_HK(bf) do { *(f16x8*)(K_lds + (bf) * SHM_K + kws) = st_k0; *(f16x8*)(K_lds + (bf) * SHM_K + kws + 32 * 256) = st_k1; } while (0)
#define SWRITE_HV(bf) do { *(f16x8*)(V_lds + (bf) * SHM_V + vst0) = st_v0; *(f16x8*)(V_lds + (bf) * SHM_V + vst1) = st_v1; } while (0)
#define SWRITE_H(bf) do { SWRITE_HV(bf); SWRITE_HK(bf); } while (0)
template <int KB, bool QREG>
__device__ __forceinline__ void qkt(f32x16& p0, f32x16& p1, const char* K_lds, const char* Qw_lds, int r32, int hi, const f16x8* qr) {
    p0 = f32x16{}; p1 = f32x16{};
    int ko[4];
#pragma unroll
    for (int dd = 0; dd < 4; ++dd) ko[dd] = KSWZ(r32, (dd * 16 + hi * 8) * 2);
#pragma unroll
    for (int d0 = 0; d0 < 8; ++d0) { const char* a = K_lds + KB * SHM_K + ko[d0 & 3] + (d0 >> 2) * 128;
        f16x8 b0 = *reinterpret_cast<const f16x8*>(a);
        f16x8 b1 = *reinterpret_cast<const f16x8*>(a + 32 * 256);
        f16x8 qf = QREG ? qr[d0] : *reinterpret_cast<const f16x8*>(Qw_lds + ko[d0 & 3] + (d0 >> 2) * 128);
        p0 = __builtin_amdgcn_mfma_f32_32x32x16_f16(b0, qf, p0, 0, 0, 0);
        p1 = __builtin_amdgcn_mfma_f32_32x32x16_f16(b1, qf, p1, 0, 0, 0); }
}
template <int KIND, bool QREG>
__device__ __forceinline__ void attn_block(const BlockRef& cur, char* lds) {
    const int tid = threadIdx.x, wid = __builtin_amdgcn_readfirstlane(tid >> 6), lane = tid & 63, r32 = lane & 31, hi = lane >> 5;
    const int NT = (cur.P0 + QB) / KVBLK;
    const int qlo = cur.P0 + wid * QBLK, qm = qlo + r32 - 4 * hi;
    char* V_lds = lds; char* K_lds = lds + 2 * SHM_V; char* Qw_lds = lds + LDS_Q + wid * 8192;
    float* ws = (float*)(lds + 2 * SHM_V + 2 * SHM_K) + wid * 64; float* li_l = ws, * al_l = ws + 32;
    float m_reg = -1e30f, l_reg = 0; f32x16 o[4] = {};
    const int sr = tid >> 4, sc = (tid & 15) * 8, vst0 = v_st(sr, sc), vst1 = v_st(32 + sr, sc), kws = KSWZ(sr, sc * 2);
    const int vb0 = (int)(uintptr_t)V_lds + v_rd_base(lane);
    const f16* Kh = cur.K; const f16* Vh = cur.V;
    f16x8 st_v0, st_v1, st_k0, st_k1; f16x8 qr[8];
    unsigned selw = 0; const int moff = (wid * QBLK + r32) * 64; u64 mcur = 0;
    if constexpr (KIND == 0) { selw = cur.sel[wid * QBLK + r32]; }
#define MLOAD(t) do { if constexpr (KIND == 1) mcur = cur.M[moff + (t)]; } while (0)
#define RESC(a) do { if (__any((a) < 1.f)) { if (hi == 0) al_l[r32] = (a); asm volatile("s_waitcnt lgkmcnt(0)" ::: "memory");              \
                     for (int d_ = 0; d_ < 4; ++d_) for (int r = 0; r < 16; ++r) o[d_][r] *= al_l[crow(r, hi)]; } } while (0)
#define KBASE(t) ((t) * KVBLK)
#define MASKT(P0_, P1_, t) do { const int kb_ = KBASE(t);                                                                                   \
        if constexpr (KIND == 0) { if (kb_ >= cur.P0) { if (kb_ + KVBLK - 1 > qlo) mask_causal(P0_, P1_, qm - kb_); }                      \
            else { const bool al_ = (selw >> (kb_ >> 8)) & 1u; if (!__all(al_)) { if (!al_) { const float NEG_ = -__builtin_inff();        \
                _Pragma("unroll") for (int r_ = 0; r_ < 16; ++r_) { P0_[r_] = NEG_; P1_[r_] = NEG_; } } } } }                             \
        else { mask_bits(P0_, P1_, (unsigned)mcur >> (4 * hi), (unsigned)(mcur >> 32) >> (4 * hi)); } } while (0)
    f32x16 pA0, pA1, pB0, pB1; float mnA, mnB, alA, alB; f16x8 pa0, pa1, pa2, pa3;
    {
#pragma unroll
        for (int d0 = 0; d0 < 8; ++d0) { const f16x8 qv = load8(cur.Q + (size_t)(wid * QBLK + r32) * D + d0 * 16 + hi * 8);
            if (QREG) qr[d0] = qv; else *(f16x8*)(Qw_lds + KSWZ(r32, (d0 * 16 + hi * 8) * 2)) = qv; }
        SLOAD_H(Kh, Vh, 0); VMW(); SWRITE_H(0);
    }
    __syncthreads();
    if (NT > 1) { SLOAD_H(Kh, Vh, KBASE(1)); }
    MLOAD(0); SBAR(); qkt<0, QREG>(pA0, pA1, K_lds, Qw_lds, r32, hi, qr); asm volatile("s_nop 15\n\ts_nop 7" : "+v"(pA0), "+v"(pA1));
    MASKT(pA0, pA1, 0); partialSM(pA0, pA1, m_reg, mnA, alA);
    if (NT > 1) { VMW(); SWRITE_H(1); }
    __syncthreads();
#define HALF_STEP(PX0, PX1, mnX, alX, PY0, PY1, alY, t, KB, VB, SB) do {                                                      \
        MLOAD(t); SBAR(); qkt<KB, QREG>(PX0, PX1, K_lds, Qw_lds, r32, hi, qr);                                                          \
        finishSM(PY0, PY1, alY, l_reg, pa0, pa1, pa2, pa3); SBAR();                                                           \
        if ((t) + 1 < NT) { SLOAD_H(Kh, Vh, KBASE((t) + 1)); SBAR(); }                                                        \
          \
        ATT_PVG(VB, 0); MASKT(PX0, PX1, (t)); const float pmx_ = sm_max(PX0, PX1); SBAR();                                    \
        ATT_PVG(VB, 1); const float mnl_ = sm_decide(pmx_, m_reg, mnX, alX); sm_fma(PX0, mnl_); SBAR();                       \
        ATT_PVG(VB, 2); sm_fma(PX1, mnl_); SBAR();                                                                            \
        ATT_PVG(VB, 3); sm_exp(PX0);                                                                                          \
        __syncthreads();                                                                                                      \
        if ((t) + 1 < NT) { VMW(); SWRITE_H(SB); }                                                                            \
        RESC(alX); __syncthreads(); } while (0)
    for (int t = 1; t + 1 < NT; t += 2) {
        HALF_STEP(pB0, pB1, mnB, alB, pA0, pA1, alA, t, 1, 0, 0);
        HALF_STEP(pA0, pA1, mnA, alA, pB0, pB1, alB, t + 1, 0, 1, 1);
    }
    MLOAD(NT - 1); SBAR(); qkt<1, QREG>(pB0, pB1, K_lds, Qw_lds, r32, hi, qr); SBAR();
    finishSM(pA0, pA1, alA, l_reg, pa0, pa1, pa2, pa3); SBAR();
    pv_tile<0>(o, vb0, pa0, pa1, pa2, pa3);
    MASKT(pB0, pB1, NT - 1); partialSM(pB0, pB1, m_reg, mnB, alB); RESC(alB);
    finishSM(pB0, pB1, alB, l_reg, pa0, pa1, pa2, pa3); SBAR(); pv_tile<1>(o, vb0, pa0, pa1, pa2, pa3);
    if (hi == 0) li_l[r32] = l_reg; asm volatile("s_waitcnt lgkmcnt(0)" ::: "memory");
    float rli[16];
#pragma unroll
    for (int r = 0; r < 16; ++r) rli[r] = __builtin_amdgcn_rcpf(li_l[crow(r, hi)]);
    int le = lane; asm volatile("" : "+v"(le));
    f16* Ow = cur.O + (size_t)(wid * QBLK) * AW; f16* stg = (f16*)(lds + LDS_Q) + wid * 4096; f16* sw = stg + (4 * (le >> 5)) * 128 + (le & 31);
#pragma unroll
    for (int r = 0; r < 16; ++r) { const int ob = ((r & 3) + 8 * (r >> 2)) * 128;
#pragma unroll
        for (int d0 = 0; d0 < 4; ++d0) sw[ob + d0 * 32] = (f16)(o[d0][r] * rli[r]); }
    asm volatile("s_waitcnt lgkmcnt(0)" ::: "memory");
    const f16* sr_ = stg + (le >> 4) * 128 + (le & 15) * 8; f16* og = Ow + (size_t)(le >> 4) * AW + (le & 15) * 8;
#pragma unroll
    for (int i = 0; i < 8; ++i) { const u32x4 v = *(const u32x4*)(sr_ + i * 4 * 128); *(u32x4*)(og + (size_t)i * 4 * AW) = v; }
    __syncthreads();
#undef RESC
#undef KBASE
#undef MASKT
#undef MLOAD
#undef HALF_STEP
}
#undef ROW
#undef VMW
#undef SLOAD_H
#undef SWRITE_HK
#undef SWRITE_HV
#undef SWRITE_H
#undef SBAR
}

constexpr int NWAVES = 8;
constexpr int RING_BYTES = 131072;
constexpr int LDSCTL_OFF = 146432, MISC_OFF = LDSCTL_OFF + 320;
constexpr int LDS_BYTES = 147456;
constexpr int CW_TMO = 0, CW_QUEUE = 64, CW_QUEUE2 = 128, CW_BAR = 4096;
typedef GAS unsigned gu32;
#define RLX_AGENT __ATOMIC_RELAXED, __HIP_MEMORY_SCOPE_AGENT

#define XB_TMO      128
#define XB_XCNT(j)  (256  + 64 * (j))
#define XB_XSUB(j)  (1280 + 64 * (j))
#define XB_XGEN(j)  (2304 + 64 * (j))
#define XB_TOP      3328
#define XB_TOPGEN   3392
#define XCD_BAR_WORDS 3456
#define XB_SPIN_CAP (1u << 20)
__device__ __forceinline__ unsigned xb_ld(unsigned* p)              { return __hip_atomic_load(p, __ATOMIC_RELAXED, __HIP_MEMORY_SCOPE_AGENT); }
__device__ __forceinline__ unsigned xb_add(unsigned* p, unsigned v) { return __hip_atomic_fetch_add(p, v, __ATOMIC_RELAXED, __HIP_MEMORY_SCOPE_AGENT); }
__device__ __forceinline__ unsigned xb_xcc_id() { return (unsigned)__builtin_amdgcn_s_getreg((3 << 11) | 20) & 0xFu; }
#define XB_SPIN(cond, bar) do { unsigned _sp = 0; while (cond) { __builtin_amdgcn_s_sleep(1); \
    if ((++_sp & 255u) == 0u) { if (xb_ld(&(bar)[XB_TMO])) break; if (_sp > XB_SPIN_CAP) { atomicAdd(&(bar)[XB_TMO], 1u); break; } } } } while (0)
struct XcdBarrier { unsigned* bar; unsigned x; volatile LAS unsigned* st; };
__device__ __forceinline__ XcdBarrier xcd_barrier_post(unsigned* bar, volatile LAS unsigned* st) {
    XcdBarrier b; b.bar = bar; b.x = xb_xcc_id(); b.st = st;
    if (threadIdx.x == 0) (void)xb_add(&bar[XB_XCNT(b.x)], 1u);
    return b;
}
__device__ __forceinline__ void xcd_barrier_complete(unsigned* bar, unsigned x, unsigned& nloc, unsigned& nx) {
    const unsigned G = gridDim.x * gridDim.y * gridDim.z;
    unsigned sum, cnt, mine, sp = 0u;
    for (;;) {
        sum = 0u; cnt = 0u; mine = 0u;
#pragma unroll
        for (unsigned j = 0; j < 16; ++j) { const unsigned c = xb_ld(&bar[XB_XCNT(j)]); sum += c; cnt += (c > 0u) ? 1u : 0u; mine = (j == x) ? c : mine; }
        if (sum == G) break;
        __builtin_amdgcn_s_sleep(1);
        if ((++sp & 255u) == 0u) { if (xb_ld(&bar[XB_TMO])) break; if (sp > XB_SPIN_CAP) { atomicAdd(&bar[XB_TMO], 1u); break; } }
    }
    nloc = mine > 0u ? mine : 1u; nx = cnt > 0u ? cnt : 1u;
}
__device__ __forceinline__ void xcd_barrier(const XcdBarrier& b) {
    asm volatile("s_waitcnt vmcnt(0)" ::: "memory");
    __syncthreads();
    if (threadIdx.x == 0) {
        unsigned* bar = b.bar;
        __builtin_amdgcn_s_waitcnt(0);
        unsigned nloc = b.st[0], nx = b.st[1];
        if (nloc == 0u) { xcd_barrier_complete(bar, b.x, nloc, nx); b.st[0] = nloc; b.st[1] = nx; }
        const unsigned old = xb_add(&bar[XB_XSUB(b.x)], 1u);
        const unsigned gen = old / nloc;
        if (old + 1u == (gen + 1u) * nloc) {
            __builtin_amdgcn_fence(__ATOMIC_RELEASE, "agent");
            asm volatile("s_waitcnt vmcnt(0)" ::: "memory");
            const unsigned og = xb_add(&bar[XB_TOP], 1u);
            const unsigned tg = og / nx;
            if (og + 1u == (tg + 1u) * nx) xb_add(&bar[XB_TOPGEN], 1u);
            else XB_SPIN(xb_ld(&bar[XB_TOPGEN]) == tg, bar);
            __builtin_amdgcn_fence(__ATOMIC_ACQUIRE, "agent");
            xb_add(&bar[XB_XGEN(b.x)], 1u);
            asm volatile("s_waitcnt vmcnt(0)" ::: "memory");
        } else {
            XB_SPIN(xb_ld(&bar[XB_XGEN(b.x)]) == gen, bar);
            __builtin_amdgcn_fence(__ATOMIC_ACQUIRE, "agent");
            asm volatile("s_waitcnt vmcnt(0)" ::: "memory");
        }
    }
    __syncthreads();
}

struct Args { const float* in[14]; float* out; unsigned char* ws; int ph_lo, ph_hi; };
constexpr int PTRTAB_OFF = LDSCTL_OFF + 512;
__device__ __forceinline__ const float* ldptr(LAS unsigned char* lds, int i) {
    const LAS unsigned* p = (const LAS unsigned*)(lds + PTRTAB_OFF) + 2 * i; asm volatile("" ::: "memory");
    const unsigned lo = __builtin_amdgcn_readfirstlane(p[0]), hi = __builtin_amdgcn_readfirstlane(p[1]);
    return (const float*)(((u64)hi << 32) | lo);
}

__device__ __forceinline__ void conv_load(f32x4 (&r)[16], const float* src0, const float* src1, int N, int lane) {
    const float* sp = (lane & 8) ? src1 : src0;
    if (sp) {
#pragma unroll
        for (int i = 0; i < 16; ++i) r[i] = __builtin_nontemporal_load((const f32x4*)(sp + (size_t)(4 * i + (lane >> 4)) * N + 4 * (lane & 7)));
    } else {
#pragma unroll
        for (int i = 0; i < 16; ++i) r[i] = (f32x4){0.f, 0.f, 0.f, 0.f};
    }
}
__device__ __forceinline__ void conv_store(const f32x4 (&r)[16], f16* dst, int K, LAS float* scr, int lane) {
#pragma unroll
    for (int i = 0; i < 16; ++i) { LAS float* wp = scr + (4 * i + (lane >> 4)) * 65 + 4 * (lane & 15); wp[0] = r[i][0]; wp[1] = r[i][1]; wp[2] = r[i][2]; wp[3] = r[i][3]; }
    LDS_WAIT(); asm volatile("" ::: "memory");
    const int c = lane & 7;
#pragma unroll
    for (int j = 0; j < 8; ++j) { const int n = (lane >> 3) + 8 * j; const LAS float* sp = scr + (8 * c) * 65 + n;
        if (K < 0) { int w0 = 0, w1 = 0;
            w0 = __builtin_amdgcn_cvt_pk_fp8_f32(sp[0 * 65] * 256.f, sp[1 * 65] * 256.f, w0, false); w0 = __builtin_amdgcn_cvt_pk_fp8_f32(sp[2 * 65] * 256.f, sp[3 * 65] * 256.f, w0, true);
            w1 = __builtin_amdgcn_cvt_pk_fp8_f32(sp[4 * 65] * 256.f, sp[5 * 65] * 256.f, w1, false); w1 = __builtin_amdgcn_cvt_pk_fp8_f32(sp[6 * 65] * 256.f, sp[7 * 65] * 256.f, w1, true);
            *(GAS u32x2*)((unsigned char*)dst + (size_t)n * (size_t)(-K) + 8 * c) = (u32x2){(unsigned)w0, (unsigned)w1}; continue; }
        u32x4 o; o.x = pkh(sp[0 * 65], sp[1 * 65]); o.y = pkh(sp[2 * 65], sp[3 * 65]); o.z = pkh(sp[4 * 65], sp[5 * 65]); o.w = pkh(sp[6 * 65], sp[7 * 65]);
        *(GAS u32x4*)(dst + (size_t)n * K + 8 * c) = o; }
    LDS_WAIT(); asm volatile("" ::: "memory");
}
template <class Dec>
__device__ __forceinline__ void conv_stream(int first, int total, int stride, const Dec& dec, LAS float* scr, int lane) {
    int it = first; if (it >= total) return;
    f32x4 ra[16], rb[16];
    const float* a0; const float* a1; f16* ad; int aK, aN; const float* b0; const float* b1; f16* bd; int bK, bN;
    dec(it, a0, a1, ad, aK, aN); b0 = a0; b1 = a1; bd = ad; bK = aK; bN = aN; conv_load(ra, a0, a1, aN, lane);
    for (;;) {
        bool more = it + stride < total; if (more) { dec(it + stride, b0, b1, bd, bK, bN); conv_load(rb, b0, b1, bN, lane); }
        conv_store(ra, ad, aK, scr, lane); if (!more) break; it += stride;
        more = it + stride < total; if (more) { dec(it + stride, a0, a1, ad, aK, aN); conv_load(ra, a0, a1, aN, lane); }
        conv_store(rb, bd, bK, scr, lane); if (!more) break; it += stride;
    }
}
__device__ __forceinline__ int win_src_col(int rb) {
    const int pn = rb >> 3, jb = rb & 7, bj = jb >> 2, qq = jb & 3;
    if (pn < 24) { const int kind6 = pn >> 2, hp = pn & 3, base = kind6 * AW;
        if ((kind6 % 3) != 2) return base + (2 * hp + (qq >> 1)) * HD + 32 * (qq & 1) + 64 * bj;
        return base + hp * 256 + 32 * jb; }
    if (pn < 28) return C_QI + (4 * (pn - 24) + qq) * IDXD + 32 * bj;
    if (pn == 28) { if (jb == 0) return C_KI; if (jb == 4) return C_KI + 32; if (jb == 1) return C_WI; return -1; }
    if (pn < 37) return C_GA + (pn - 29) * 256 + 32 * jb;
    return C_GB + (pn - 37) * 256 + 32 * jb;
}
constexpr int CONV_I_IN = (DM / 64) * (N_IN_PAD / 64), CONV_I_MO = (AW / 64) * (DM / 64), CONV_I_O = (DM / 64) * (DM / 64), CONV_I_1 = (DM / 64) * (FF / 64), CONV_I_2 = (FF / 64) * (DM / 64);
constexpr int CONV_TOTAL = CONV_I_IN + 2 * CONV_I_MO + CONV_I_O + CONV_I_1 + CONV_I_2;
constexpr int CONV_SPLIT = CONV_I_IN + 2 * CONV_I_MO + CONV_I_O;
__device__ __forceinline__ void conv_items(unsigned char* ws, const float* win, const float* wmo, const float* wdo, const float* wo, const float* w1, const float* w2,
                                           LAS unsigned char* lds, int lo, int hi, int first, int stride, int wave, int lane) {
    constexpr int I_IN = CONV_I_IN, I_MO = CONV_I_MO, I_O = CONV_I_O, I_1 = CONV_I_1;
    LAS float* scr64 = (LAS float*)(lds + wave * 16640);
    conv_stream(lo + first, hi, stride, [&](int r, const float*& s0, const float*& s1, f16*& dst, int& K, int& N) {
            if (r < I_IN) { const int nb = N_IN_PAD / 64, kb = r / nb, rbd = r % nb; const float* base = win + (size_t)kb * 64 * D_IN; N = D_IN;
                const bool f8 = rbd >= 84; const int q = f8 ? rbd - 84 : rbd, p_ = q >> 2, pt = f8 ? (p_ < 4 ? 8 + p_ : (p_ < 8 ? 16 + p_ : 21 + p_)) : (p_ < 8 ? p_ : (p_ < 16 ? p_ + 4 : p_ + 8));
                const int rb = pt * 4 + (q & 3), c0 = win_src_col(2 * rb), c1 = win_src_col(2 * rb + 1);
                s0 = c0 >= 0 ? base + c0 : nullptr; s1 = c1 >= 0 ? base + c1 : nullptr;
                if (f8) { dst = (f16*)((unsigned char*)(ws + WS_WG8) + (size_t)q * 64 * DM + kb * 64); K = -DM; } else { dst = (f16*)(ws + WS_WIN) + (size_t)q * 64 * DM + kb * 64; K = DM; }
                return; }
            r -= I_IN; const float* W; f16* WT;
            if (r < I_MO) { W = wmo; WT = (f16*)(ws + WS_WMO); K = AW; N = DM; }
            else if ((r -= I_MO) < I_MO) { W = wdo; WT = (f16*)(ws + WS_WDO); K = AW; N = DM; }
            else if ((r -= I_MO) < I_O) { const int nb = DM / 64, kb = r / nb, rb = r % nb;
                s0 = wo + (size_t)kb * 64 * DM + rb * 64; s1 = s0 + 32; dst = (f16*)((unsigned char*)(ws + WS_WO) + (size_t)rb * 64 * DM + kb * 64); K = -DM; N = DM; return; }
            else if ((r -= I_O) < I_1) { W = w1; WT = (f16*)(ws + WS_W1); K = DM; N = FF; }
            else { r -= I_1; const int nb = DM / 64, kb = r / nb, rb = r % nb;
                s0 = w2 + (size_t)kb * 64 * DM + rb * 64; s1 = s0 + 32; dst = (f16*)((unsigned char*)(ws + WS_W2) + (size_t)rb * 64 * FF + kb * 64); K = -FF; N = DM; return; }
            const int nb = N / 64, kb = r / nb, rb = r % nb;
            s0 = W + (size_t)kb * 64 * N + rb * 64; s1 = s0 + 32; dst = WT + (size_t)rb * 64 * K + kb * 64; }, scr64, lane);
}
__device__ __forceinline__ void p0_prologue(const Args& a, LAS unsigned char* lds, int vcu, int G, int wave, int lane, int tid) {
    unsigned char* ws = a.ws;
    LAS float* scr = (LAS float*)(lds + wave * 16384);
    const int gw = vcu * NWAVES + wave, NGW = G * NWAVES;
    {
        const float* c = a.in[1]; const float* wada = a.in[2]; float* modp = (float*)(ws + WS_MODP);
        for (int it = gw; it < 64 * 32; it += NGW) {
            const int cc = it & 63, kc = it >> 6, k0 = kc * 64;
            if (lane < 48) {
                f32x4 a0 = {0.f, 0.f, 0.f, 0.f}, a1 = {0.f, 0.f, 0.f, 0.f};
                const float* wp = wada + (size_t)k0 * (6 * DM) + cc * 192 + lane * 4;
#pragma unroll 16
                for (int kk = 0; kk < 64; ++kk) {
                    const f32x4 wv = __builtin_nontemporal_load((const f32x4*)(wp + (size_t)kk * (6 * DM)));
                    const float c0 = c[k0 + kk], c1 = c[DM + k0 + kk];
                    const float s0 = c0 * sigmoidf_(c0), s1 = c1 * sigmoidf_(c1);
                    a0 += wv * s0; a1 += wv * s1;
                }
                *(f32x4*)(modp + (size_t)(kc * 2 + 0) * (6 * DM) + cc * 192 + lane * 4) = a0;
                *(f32x4*)(modp + (size_t)(kc * 2 + 1) * (6 * DM) + cc * 192 + lane * 4) = a1;
            }
        }
    }
    conv_items(ws, a.in[6], a.in[7], a.in[8], a.in[9], a.in[12], a.in[13], lds, 0, CONV_SPLIT, gw, NGW, wave, lane);
    {
        float* ra = (float*)(ws + WS_ROPEA); float* rb = (float*)(ws + WS_ROPEB);
        const int gt = vcu * (NWAVES * 64) + tid, NGT = G * NWAVES * 64;
        for (int i = gt; i < SEQ * 64 + SEQ * 32; i += NGT) {
            int t, f, half; float* dst;
            if (i < SEQ * 64) { t = i >> 6; f = i & 63; half = 64; dst = ra + (size_t)(i >> 2) * 8 + (i & 3); } else { const int j = i - SEQ * 64; t = j >> 5; f = j & 31; half = 32; dst = rb + (size_t)(j >> 2) * 8 + (j & 3); }
            const float inv = (float)exp2(-(double)f / (double)half * 13.287712379549449);
            const float ang = (float)t * inv;
            double sn, cs; sn = sin((double)ang); cs = cos((double)ang);
            dst[0] = (float)cs; dst[4] = (float)sn;
        }
    }
}

__device__ __forceinline__ f32x4 mod4(const float* modp, const float* bada, int b, int j) {
    f32x4 s = *(const f32x4*)(bada + j);
#pragma unroll
    for (int kc = 0; kc < 32; ++kc) s += *(const f32x4*)(modp + (size_t)(kc * 2 + b) * (6 * DM) + j);
    return s;
}
__device__ __forceinline__ void p1_norm_in(const Args& a, LAS unsigned char* lds, int vcu, int G, int wave, int lane, int tid) {
    unsigned char* ws = a.ws; const float* x = a.in[0]; const float* modp = (const float*)(ws + WS_MODP); const float* bada = a.in[3]; const float* g = a.in[4];
    f16* h = (f16*)(ws + WS_H);
    LAS float* A1 = (LAS float*)lds; LAS float* B1 = A1 + DM;
    int curb = -1;
    { float* modf = (float*)(ws + WS_MODF); const int per = (2 * 6 * DM + G - 1) / G;
      for (int e = tid; e < per; e += NWAVES * 64) { const int idx = vcu * per + e; if (idx < 2 * 6 * DM) { const int b = idx / (6 * DM), j = idx % (6 * DM); float sacc = bada[j];
          for (int kc = 0; kc < 32; ++kc) sacc += modp[(size_t)(kc * 2 + b) * (6 * DM) + j]; modf[idx] = sacc; } } }
    for (int rg = vcu; rg < MTOK / 32; rg += G) {
        const int b = rg >> 7;
        if (b != curb) { __syncthreads(); curb = b; const int j = tid * 4;
            const f32x4 sh = mod4(modp, bada, b, 0 * DM + j), sc = mod4(modp, bada, b, 1 * DM + j), gg = *(const f32x4*)(g + j);
            *(LAS f32x4*)(A1 + j) = gg * (1.0f + sc); *(LAS f32x4*)(B1 + j) = sh; __syncthreads(); }
        f32x4 v[8], vn[8];
        { const f32x4* xr = (const f32x4*)(x + (size_t)(rg * 32 + wave * 4) * DM) + lane;
#pragma unroll
          for (int j = 0; j < 8; ++j) v[j] = __builtin_nontemporal_load(xr + 64 * j); }
#pragma unroll
        for (int rr = 0; rr < 4; ++rr) { const int row = rg * 32 + wave * 4 + rr;
            if (rr < 3) { const f32x4* xr = (const f32x4*)(x + (size_t)(row + 1) * DM) + lane;
#pragma unroll
                for (int j = 0; j < 8; ++j) vn[j] = __builtin_nontemporal_load(xr + 64 * j); }
            float ss = 0.f;
#pragma unroll
            for (int j = 0; j < 8; ++j) ss += (v[j][0] * v[j][0] + v[j][1] * v[j][1]) + (v[j][2] * v[j][2] + v[j][3] * v[j][3]);
            const float rstd = 1.0f / sqrtf(wave_sum(ss) * (1.0f / DM) + RMS_EPS);
            u32x2* o8 = (u32x2*)(h + (size_t)row * DM) + lane; unsigned* o4 = (unsigned*)((unsigned char*)(ws + WS_H8) + (size_t)row * DM) + lane;
#pragma unroll
            for (int j = 0; j < 8; ++j) { const int c = 4 * lane + 256 * j; const f32x4 aa = *(LAS f32x4*)(A1 + c), bb = *(LAS f32x4*)(B1 + c); const f32x4 r = v[j] * rstd * aa + bb;
                u32x2 w; w.x = pkh(r[0], r[1]); w.y = pkh(r[2], r[3]); o8[64 * j] = w;
                int w8 = 0; w8 = __builtin_amdgcn_cvt_pk_fp8_f32(r[0], r[1], w8, false); w8 = __builtin_amdgcn_cvt_pk_fp8_f32(r[2], r[3], w8, true); o4[64 * j] = (unsigned)w8; }
#pragma unroll
            for (int j = 0; j < 8; ++j) v[j] = vn[j]; }
    }
}
__device__ __forceinline__ void p7_mid(const Args& a, LAS unsigned char* lds, int vcu, int G, int wave, int lane, int tid) {
    unsigned char* ws = (unsigned char*)ldptr(lds, 6); const float* x = ldptr(lds, 0); const float* modp = (const float*)(ws + WS_MODP); const float* bada = ldptr(lds, 1);
    const float* gpost = ldptr(lds, 2); const float* gpre = ldptr(lds, 3);
    const f16* z = (const f16*)(ws + WS_QKV + 32 * MiB); const float* ssp = (const float*)(ws + WS_SSP1); f16* h2 = (f16*)(ws + WS_H); f16* x1o = (f16*)(ws + WS_WIN);
    LAS float* G1 = (LAS float*)lds; LAS float* A2 = G1 + DM; LAS float* B2 = A2 + DM;
    int curb = -1;
    for (int rg = vcu; rg < MTOK / 32; rg += G) {
        const int b = rg >> 7;
        if (b != curb) { __syncthreads(); curb = b; const int j = tid * 4;
            const float* modf = (const float*)(ws + WS_MODF) + (size_t)b * (6 * DM);
            const f32x4 gt1 = *(const f32x4*)(modf + 2 * DM + j), sh2 = *(const f32x4*)(modf + 3 * DM + j), sc2 = *(const f32x4*)(modf + 4 * DM + j);
            *(LAS f32x4*)(G1 + j) = gt1 * *(const f32x4*)(gpost + j); *(LAS f32x4*)(A2 + j) = *(const f32x4*)(gpre + j) * (1.0f + sc2); *(LAS f32x4*)(B2 + j) = sh2; __syncthreads(); }
        f32x4 xv[8], xn[8]; u32x2 zv[8], zn[8]; float spv, spn = 0.f;
        { const int row = rg * 32 + wave * 4; const f32x4* xr = (const f32x4*)(x + (size_t)row * DM) + lane; const u32x2* zr = (const u32x2*)(z + (size_t)row * DM) + lane;
          spv = lane < 32 ? ssp[(size_t)row * 32 + lane] : 0.f;
#pragma unroll
          for (int j = 0; j < 8; ++j) { xv[j] = __builtin_nontemporal_load(xr + 64 * j); zv[j] = __builtin_nontemporal_load(zr + 64 * j); } }
#pragma unroll
        for (int rr = 0; rr < 4; ++rr) { const int row = rg * 32 + wave * 4 + rr;
            if (rr < 3) { const f32x4* xr = (const f32x4*)(x + (size_t)(row + 1) * DM) + lane; const u32x2* zr = (const u32x2*)(z + (size_t)(row + 1) * DM) + lane;
                spn = lane < 32 ? ssp[(size_t)(row + 1) * 32 + lane] : 0.f;
#pragma unroll
                for (int j = 0; j < 8; ++j) { xn[j] = __builtin_nontemporal_load(xr + 64 * j); zn[j] = __builtin_nontemporal_load(zr + 64 * j); } }
            const float rstd1 = 1.0f / sqrtf(wave_sum(spv) * (1.0f / DM) + RMS_EPS);
            u32x2* xo = (u32x2*)(x1o + (size_t)row * DM) + lane;
            f32x4 v[8]; float ss = 0.f;
#pragma unroll
            for (int j = 0; j < 8; ++j) { const int c = 4 * lane + 256 * j; const f32x2 z0 = unpkh(zv[j].x), z1 = unpkh(zv[j].y); const f32x4 zz = {z0.x, z0.y, z1.x, z1.y};
                v[j] = xv[j] + *(LAS f32x4*)(G1 + c) * zz * rstd1; { u32x2 xw; xw.x = pkh(v[j][0], v[j][1]); xw.y = pkh(v[j][2], v[j][3]); xo[64 * j] = xw; }
                ss += (v[j][0] * v[j][0] + v[j][1] * v[j][1]) + (v[j][2] * v[j][2] + v[j][3] * v[j][3]); }
            const float rstd2 = 1.0f / sqrtf(wave_sum(ss) * (1.0f / DM) + RMS_EPS);
            u32x2* o8 = (u32x2*)(h2 + (size_t)row * DM) + lane;
#pragma unroll
            for (int j = 0; j < 8; ++j) { const int c = 4 * lane + 256 * j; const f32x4 r = v[j] * rstd2 * *(LAS f32x4*)(A2 + c) + *(LAS f32x4*)(B2 + c);
                u32x2 w; w.x = pkh(r[0], r[1]); w.y = pkh(r[2], r[3]); o8[64 * j] = w; }
#pragma unroll
            for (int j = 0; j < 8; ++j) { xv[j] = xn[j]; zv[j] = zn[j]; }
            spv = spn; }
    }
}
__device__ __forceinline__ void p10_final(const Args& a, LAS unsigned char* lds, int vcu, int G, int wave, int lane, int tid) {
    unsigned char* ws = (unsigned char*)ldptr(lds, 6); const float* modp = (const float*)(ws + WS_MODP); const float* bada = ldptr(lds, 1); const float* gpost = ldptr(lds, 4);
    const f16* f = (const f16*)(ws + WS_F); const float* ssp = (const float*)(ws + WS_SSP2); float* out = (float*)ldptr(lds, 5); const f16* x1h = (const f16*)(ws + WS_WIN);
    LAS float* G2 = (LAS float*)lds;
    int curb = -1;
    for (int rg = vcu; rg < MTOK / 32; rg += G) {
        const int b = rg >> 7;
        if (b != curb) { __syncthreads(); curb = b; const int j = tid * 4;
            const f32x4 gt2 = *(const f32x4*)((const float*)(ws + WS_MODF) + (size_t)b * (6 * DM) + 5 * DM + j); *(LAS f32x4*)(G2 + j) = gt2 * *(const f32x4*)(gpost + j); __syncthreads(); }
        u32x2 fv[8], fn[8], xv[8], xn[8]; float spv, spn = 0.f;
        { const int row = rg * 32 + wave * 4; const u32x2* fr = (const u32x2*)(f + (size_t)row * DM) + lane; const u32x2* xr = (const u32x2*)(x1h + (size_t)row * DM) + lane;
          spv = lane < 32 ? ssp[(size_t)row * 32 + lane] : 0.f;
#pragma unroll
          for (int j = 0; j < 8; ++j) { fv[j] = __builtin_nontemporal_load(fr + 64 * j); xv[j] = __builtin_nontemporal_load(xr + 64 * j); } }
#pragma unroll
        for (int rr = 0; rr < 4; ++rr) { const int row = rg * 32 + wave * 4 + rr;
            if (rr < 3) { const u32x2* fr = (const u32x2*)(f + (size_t)(row + 1) * DM) + lane; const u32x2* xr = (const u32x2*)(x1h + (size_t)(row + 1) * DM) + lane;
                spn = lane < 32 ? ssp[(size_t)(row + 1) * 32 + lane] : 0.f;
#pragma unroll
                for (int j = 0; j < 8; ++j) { fn[j] = __builtin_nontemporal_load(fr + 64 * j); xn[j] = __builtin_nontemporal_load(xr + 64 * j); } }
            const float rstd = 1.0f / sqrtf(wave_sum(spv) * (1.0f / DM) + RMS_EPS);
            f32x4* xo = (f32x4*)(out + (size_t)row * DM) + lane;
#pragma unroll
            for (int j = 0; j < 8; ++j) { const int c = 4 * lane + 256 * j; const f32x2 f0 = unpkh(fv[j].x), f1 = unpkh(fv[j].y); const f32x4 ff = {f0.x, f0.y, f1.x, f1.y};
                const f32x2 x0 = unpkh(xv[j].x), x1v = unpkh(xv[j].y); const f32x4 xx = {x0.x, x0.y, x1v.x, x1v.y};
                __builtin_nontemporal_store(xx + *(LAS f32x4*)(G2 + c) * ff * rstd, xo + 64 * j); }
#pragma unroll
            for (int j = 0; j < 8; ++j) { fv[j] = fn[j]; xv[j] = xn[j]; }
            spv = spn; }
    }
}

__device__ __forceinline__ unsigned fkey(float f) { const unsigned u = __float_as_uint(f); return (u & 0x80000000u) ? ~u : (u | 0x80000000u); }
#define SEL_BODY(NC_)         { \
            const int t = t0 + wave; LAS unsigned* row = sc + wave * SEQ; \
            float v[NC_]; \
_Pragma("unroll") \
            for (int i = 0; i < NC_; ++i) v[i] = __uint_as_float(row[i * 64 + lane]); \
            float thr = -__builtin_inff(); \
            if (t + 1 > DSA_TOPK) { \
                float mx = -__builtin_inff(), mn = __builtin_inff(); \
_Pragma("unroll") \
                for (int i = 0; i < NC_; ++i) { asm("v_max_f32 %0, %0, %1" : "+v"(mx) : "v"(v[i])); asm("v_min_f32 %0, %0, %1" : "+v"(mn) : "v"(v[i])); } \
_Pragma("unroll") \
                for (int o = 1; o < 64; o <<= 1) { mx = __builtin_fmaxf(mx, __shfl_xor(mx, o)); mn = __builtin_fminf(mn, __shfl_xor(mn, o)); } \
                const float scale = (mx > mn) ? 4094.5f / (mx - mn) : 0.f, off = -mn * scale; \
                LDS_WAIT(); \
_Pragma("unroll") \
                for (int i = 0; i < 16; ++i) *(LAS u32x4*)(row + (i * 64 + lane) * 4) = (u32x4){0u, 0u, 0u, 0u}; \
                LDS_WAIT(); \
_Pragma("unroll") \
                for (int i = 0; i < NC_; ++i) { \
                    const unsigned bb = (v[i] == v[i]) ? (unsigned)(int)__builtin_fmaf(v[i], scale, off) : (unsigned)lane; \
                    __hip_atomic_fetch_add(row + bb, 1u, __ATOMIC_RELAXED, __HIP_MEMORY_SCOPE_WORKGROUP); \
                    if ((i & 7) == 7) __builtin_amdgcn_sched_barrier(0); } \
                __hip_atomic_fetch_sub(row + lane, (unsigned)(NC_ - 1 - ((t - lane) >> 6)), __ATOMIC_RELAXED, __HIP_MEMORY_SCOPE_WORKGROUP); \
                LDS_WAIT(); \
                unsigned qs[16], S = 0; \
_Pragma("unroll") \
                for (int i = 0; i < 16; ++i) { const u32x4 h4 = *(const LAS u32x4*)(row + lane * 64 + i * 4); qs[i] = (h4.x + h4.y) + (h4.z + h4.w); S += qs[i]; if ((i & 3) == 3) __builtin_amdgcn_sched_barrier(0); } \
                unsigned suf = S; \
_Pragma("unroll") \
                for (int o = 1; o < 64; o <<= 1) { const unsigned y = __shfl_down(suf, o); suf += (lane + o < 64) ? y : 0u; } \
                const unsigned above = suf - S; \
                unsigned run = above; int qB = 0; unsigned runq = above; bool found = false; \
_Pragma("unroll") \
                for (int qd = 15; qd >= 0; --qd) { const bool hit = !found && (run + qs[qd] >= (unsigned)DSA_TOPK); if (hit) { qB = qd; runq = run; found = true; } run += qs[qd]; } \
                unsigned jB = 0, cabv = 0; \
                { const u32x4 h4 = *(const LAS u32x4*)(row + lane * 64 + qB * 4); unsigned r2 = runq; bool f2 = false; \
_Pragma("unroll") \
                  for (int e = 3; e >= 0; --e) { const bool hit = !f2 && (r2 + h4[e] >= (unsigned)DSA_TOPK); if (hit) { jB = (unsigned)(qB * 4 + e); cabv = r2; f2 = true; } r2 += h4[e]; } } \
                const u64 crossing = __ballot(above < (unsigned)DSA_TOPK && suf >= (unsigned)DSA_TOPK); \
                const int L = (int)__builtin_ctzll(crossing); \
                const unsigned B = (unsigned)__builtin_amdgcn_readlane((int)(jB + 64u * lane), L), cab = (unsigned)__builtin_amdgcn_readlane((int)cabv, L); \
                const int need = DSA_TOPK - (int)cab; \
                LDS_WAIT(); \
                const float blo = B ? (float)B : -__builtin_inff(), bhi = (float)(B + 1); \
                int occ = 0; \
_Pragma("unroll") \
                for (int i = 0; i < NC_; ++i) { float vi = v[i]; asm volatile("" : "+v"(vi)); \
                    const float x = __builtin_fmaf(vi, scale, off); const bool c = (x >= blo) && (x < bhi); \
                    const u64 m = __ballot(c); \
                    if (m) { const int pos = occ + (int)__builtin_popcountll(m & ((1ull << lane) - 1ull)); if (c && pos < 64) row[pos] = __float_as_uint(vi); occ += (int)__builtin_popcountll(m); } \
                    __builtin_amdgcn_sched_barrier(0); } \
                LDS_WAIT(); \
                if (occ <= 64) { \
                    const float cl = (lane < occ) ? __uint_as_float(row[lane]) : -__builtin_inff(); int gt = 0, ge = 0; \
                    for (int j = 0; j < occ; ++j) { const float x = __uint_as_float(row[j]); gt += (x > cl) ? 1 : 0; ge += (x >= cl) ? 1 : 0; } \
                    const u64 hitm = __ballot(lane < occ && gt < need && need <= ge); \
                    thr = __uint_as_float((unsigned)__builtin_amdgcn_readlane((int)__float_as_uint(cl), (int)__builtin_ctzll(hitm))); \
                } else { \
                    unsigned tk = 0u; \
                    for (int bit = 31; bit >= 0; --bit) { const unsigned cand = tk | (1u << bit); unsigned cl = 0; \
_Pragma("unroll") \
                        for (int i = 0; i < NC_; ++i) { float vi = v[i]; asm volatile("" : "+v"(vi)); cl += (vi == vi && fkey(vi) >= cand) ? 1u : 0u; } \
                        int cnt = 0; \
_Pragma("unroll") \
                        for (int bb = 0; bb < 7; ++bb) cnt += (int)__builtin_popcountll(__ballot((cl >> bb) & 1u)) << bb; \
                        if (cnt >= DSA_TOPK) tk = cand; } \
                    const unsigned ub = (tk & 0x80000000u) ? (tk ^ 0x80000000u) : ~tk; thr = __uint_as_float(ub); \
                } \
            } \
            int mlo = 0, mhi = 0; \
_Pragma("unroll") \
            for (int g4 = 0; g4 < NC_ / 4; ++g4) { const u64 m0 = __ballot(v[4 * g4] >= thr), m1 = __ballot(v[4 * g4 + 1] >= thr), m2 = __ballot(v[4 * g4 + 2] >= thr), m3 = __ballot(v[4 * g4 + 3] >= thr); \
                asm volatile("s_nop 1\n\tv_writelane_b32 %0, %2, %10\n\tv_writelane_b32 %1, %3, %10\n\tv_writelane_b32 %0, %4, %11\n\tv_writelane_b32 %1, %5, %11\n\t" \
                             "v_writelane_b32 %0, %6, %12\n\tv_writelane_b32 %1, %7, %12\n\tv_writelane_b32 %0, %8, %13\n\tv_writelane_b32 %1, %9, %13" \
                             : "+v"(mlo), "+v"(mhi) : "s"((unsigned)m0), "s"((unsigned)(m0 >> 32)), "s"((unsigned)m1), "s"((unsigned)(m1 >> 32)), "s"((unsigned)m2), "s"((unsigned)(m2 >> 32)), \
                               "s"((unsigned)m3), "s"((unsigned)(m3 >> 32)), "n"(4 * g4), "n"(4 * g4 + 1), "n"(4 * g4 + 2), "n"(4 * g4 + 3)); } \
            mask[(size_t)(tok0 + wave) * 64 + lane] = ((u64)(unsigned)mhi << 32) | (unsigned)mlo; \
        }
__device__ __forceinline__ void p3_indexer(const Args& a, LAS unsigned char* lds, int vcu, int G, int wave, int lane, int tid) {
    unsigned char* ws = a.ws;
    {
        const f16* Ka = (const f16*)(ws + WS_QKV) + 1 * QKV_ONE; float* km = (float*)(ws + WS_KMEAN);
        LAS float* red = (LAS float*)lds;
        for (int it = vcu; it < BATCH * NH * (MOBA_NB - 1); it += G) {
            const int n = it % (MOBA_NB - 1), bh = it / (MOBA_NB - 1), rg = tid >> 4, cc = tid & 15;
            const f16* p = Ka + ((size_t)bh * SEQ + n * MOBA_BLOCK + rg) * HD + cc * 8;
            f16x8 v[8];
#pragma unroll
            for (int r = 0; r < 8; ++r) v[r] = *(const f16x8*)(p + (size_t)r * 32 * HD);
            float acc[8];
#pragma unroll
            for (int e = 0; e < 8; ++e) { acc[e] = 0.f;
#pragma unroll
                for (int r = 0; r < 8; ++r) acc[e] += (float)v[r][e]; }
            __syncthreads();
#pragma unroll
            for (int e = 0; e < 8; ++e) red[rg * 128 + cc * 8 + e] = acc[e];
            __syncthreads();
            if (tid < 128) { float sum = 0.f;
#pragma unroll
                for (int r = 0; r < 32; ++r) sum += red[r * 128 + tid];
                const int b = bh / NH, hh = bh % NH;
                km[((size_t)(b * MOBA_NB + n) * NH + hh) * HD + tid] = sum * (1.0f / MOBA_BLOCK); }
        }
        __syncthreads();
    }
    const f16* qidx = (const f16*)(ws + WS_QIDX); const f16* kidx = (const f16*)(ws + WS_KIDX); const float* widx = (const float*)(ws + WS_WIDX); u64* mask = (u64*)(ws + WS_MASK);
    LAS unsigned* sc = (LAS unsigned*)lds;
    const int r32 = lane & 31, hi = lane >> 5;
    f16x8 qa[4][4]; f16x8 kA[4], kB[4]; float wnext = 0.f;
    LAS float* wl = (LAS float*)(lds + 131072);
#define IDX_DECODE(uu_, b_, t0_, ntile_) const int kq_ = (uu_) >> 8, cq_ = (uu_) & 255; b_ = (kq_ >> 1) & 1; t0_ = ((kq_ & 1) ? 511 - cq_ : cq_) * 8; ntile_ = ((t0_ + 8 + 63) >> 6) << 1
#define IDX_LOAD_UNIT(uu_) do { int b_, t0_, nt_; IDX_DECODE(uu_, b_, t0_, nt_); const int tok0_ = b_ * SEQ + t0_; int r32 = lane & 31, hi = lane >> 5; asm volatile("" : "+v"(r32), "+v"(hi));                                       \
        _Pragma("unroll") for (int mt = 0; mt < 4; ++mt) { const int tok = tok0_ + 2 * mt + (r32 >> 4), head = r32 & 15;                               \
            _Pragma("unroll") for (int ks = 0; ks < 4; ++ks) qa[mt][ks] = *(const f16x8*)(qidx + (size_t)tok * (IDXH * IDXD) + head * IDXD + ks * 16 + hi * 8); } \
        if (tid < 128) wnext = widx[(size_t)tok0_ * IDXH + tid];                                                                                       \
        const f16* kb_ = kidx + (size_t)(b_ * SEQ + r32) * IDXD + hi * 8;                                                                              \
        if (wave < nt_) { _Pragma("unroll") for (int ks = 0; ks < 4; ++ks) kA[ks] = *(const f16x8*)(kb_ + (size_t)wave * 32 * IDXD + ks * 16); }       \
        if (wave + NWAVES < nt_) { _Pragma("unroll") for (int ks = 0; ks < 4; ++ks) kB[ks] = *(const f16x8*)(kb_ + (size_t)(wave + NWAVES) * 32 * IDXD + ks * 16); } } while (0)
#define RELU_(x) __builtin_amdgcn_fmed3f((x), 0.f, 3.0e38f)
#define IDX_TILE(KF, j_) do {                                                                                                                          \
        unsigned wa_ = (unsigned)(size_t)(wl + 4 * hi), sa_ = (unsigned)(size_t)(sc + hi * SEQ + (j_) * 32 + r32); asm volatile("" : "+v"(wa_), "+v"(sa_));     \
        const bool edge_ = (j_) * 32 + 31 > t0;                                                                                                         \
        _Pragma("unroll") for (int mt = 0; mt < 4; ++mt) { f32x16 c = {};                                                                              \
            const LAS f32x4* wp_ = (const LAS f32x4*)(size_t)wa_;                                                                                      \
            const f32x4 wa0 = wp_[(2 * mt) * 4], wa1 = wp_[(2 * mt) * 4 + 2], wb0 = wp_[(2 * mt + 1) * 4], wb1 = wp_[(2 * mt + 1) * 4 + 2];            \
            _Pragma("unroll") for (int ks = 0; ks < 4; ++ks) c = __builtin_amdgcn_mfma_f32_32x32x16_f16(qa[mt][ks], KF[ks], c, 0, 0, 0);               \
            float s0 = 0.f, s1 = 0.f;                                                                                                                  \
            _Pragma("unroll") for (int r = 0; r < 4; ++r) { s0 = fmaf(wa0[r], RELU_(c[r]), s0); s0 = fmaf(wa1[r], RELU_(c[4 + r]), s0);                 \
                                                          s1 = fmaf(wb0[r], RELU_(c[8 + r]), s1); s1 = fmaf(wb1[r], RELU_(c[12 + r]), s1); }            \
            auto rr = __builtin_amdgcn_permlane32_swap(__float_as_uint(s0), __float_as_uint(s1), false, false);                                        \
            unsigned sv = __float_as_uint(__uint_as_float(rr[0]) + __uint_as_float(rr[1]));     \
            if (edge_) sv = ((j_) * 32 + r32 <= t0 + 2 * mt + hi) ? sv : 0x7FC00000u;                                                                  \
            ((LAS unsigned*)(size_t)(sa_ + (mt >> 1) * 65536))[(mt & 1) * 2 * SEQ] = sv; } } while (0)
    if (vcu < 2 * 512) { IDX_LOAD_UNIT(vcu); if (tid < 128) wl[tid] = wnext; }
    __syncthreads();
    for (int uu = vcu; uu < 2 * 512; uu += G) {
        int b, t0, ntile; IDX_DECODE(uu, b, t0, ntile); const int tok0 = b * SEQ + t0;
        int r32o = r32, hio = hi; asm volatile("" : "+v"(r32o), "+v"(hio));
        const f16* kbase = kidx + (size_t)(b * SEQ + r32o) * IDXD + hio * 8;
        for (int q = 0; q < 8; ++q) for (int c4 = ntile * 8 + tid; c4 < SEQ / 4; c4 += NWAVES * 64) *(LAS u32x4*)(sc + q * SEQ + c4 * 4) = (u32x4){0x7FC00000u, 0x7FC00000u, 0x7FC00000u, 0x7FC00000u};
        {
        for (int j = wave; j < ntile; j += 2 * NWAVES) {
            f16x8 k0[4], k1[4];
#pragma unroll
            for (int ks = 0; ks < 4; ++ks) { k0[ks] = kA[ks]; k1[ks] = kB[ks]; }
            if (j + 2 * NWAVES < ntile) {
#pragma unroll
                for (int ks = 0; ks < 4; ++ks) kA[ks] = *(const f16x8*)(kbase + (size_t)(j + 2 * NWAVES) * 32 * IDXD + ks * 16);
            }
            if (j + 3 * NWAVES < ntile) {
#pragma unroll
                for (int ks = 0; ks < 4; ++ks) kB[ks] = *(const f16x8*)(kbase + (size_t)(j + 3 * NWAVES) * 32 * IDXD + ks * 16);
            }
            IDX_TILE(k0, j);
            if (j + NWAVES < ntile) IDX_TILE(k1, j + NWAVES);
        } }
        __syncthreads();
        if (uu + G < 2 * 512) { IDX_LOAD_UNIT(uu + G); }
        switch ((t0 + wave) >> 10) { case 0: SEL_BODY(16) break; case 1: SEL_BODY(32) break; case 2: SEL_BODY(48) break; default: SEL_BODY(64) break; }
        if (tid < 128) wl[tid] = wnext;
        __syncthreads();
    }
}
#undef SEL_BODY
#undef IDX_DECODE
#undef IDX_LOAD_UNIT
#undef IDX_TILE
#undef RELU_

__device__ __forceinline__ void moba_select(const f16* Q, const float* km_bh  , int qb, LAS unsigned* selm, LAS float* kml, int tid) {
    for (int i = tid; i < 15 * HD; i += NWAVES * 64) { const int n = i >> 7, d = i & 127; kml[i] = (n < qb) ? km_bh[(size_t)n * NH * HD + d] : 0.f; }
    __syncthreads();
    const int q = tid >> 1, half = tid & 1;
    float gsc[15];
#pragma unroll
    for (int n = 0; n < 15; ++n) gsc[n] = 0.f;
    const f16* qp = Q + (size_t)q * HD + half * 64;
#pragma unroll
    for (int c = 0; c < 8; ++c) { const f16x8 qv = *(const f16x8*)(qp + c * 8);
#pragma unroll
        for (int n = 0; n < 15; ++n) { const LAS f32x4* kp = (const LAS f32x4*)(kml + n * HD + half * 64 + c * 8); const f32x4 k0 = kp[0], k1 = kp[1];
#pragma unroll
            for (int e = 0; e < 4; ++e) { gsc[n] = fmaf((float)qv[e], k0[e], gsc[n]); gsc[n] = fmaf((float)qv[4 + e], k1[e], gsc[n]); } } }
    unsigned m = 0;
#pragma unroll
    for (int n = 0; n < 15; ++n) gsc[n] += __shfl_xor(gsc[n], 1);
#pragma unroll
    for (int pass = 0; pass < MOBA_TOPK; ++pass) { float best = -__builtin_inff(); int bi = -1;
#pragma unroll
        for (int n = 0; n < 15; ++n) { const bool ok = (n < qb) && !((m >> n) & 1u) && (gsc[n] > best); if (ok) { best = gsc[n]; bi = n; } }
        if (bi >= 0) m |= 1u << bi; }
    if (half == 0) selm[q] = m;
    __syncthreads();
}
__device__ __forceinline__ void p4_attention(const Args& a, LAS unsigned char* ldsl, char* lds, int vcu, int G, int tid) {
    unsigned char* ws = a.ws;
    const f16* qkv = (const f16*)(ws + WS_QKV); f16* Obase = (f16*)(ws + WS_H); const u64* mask = (const u64*)(ws + WS_MASK); const float* km = (const float*)(ws + WS_KMEAN);
    LAS unsigned* selm = (LAS unsigned*)(ldsl + att::LDS_SELM); LAS float* kml = (LAS float*)(ldsl + att::LDS_KM);
    unsigned* ctr = (unsigned*)(ws + WS_CTL) + CW_QUEUE; LAS int* nxt = (LAS int*)(ldsl + LDSCTL_OFF + 64);
    for (;;) {
        __syncthreads();
        if (tid == 0) *nxt = (int)__hip_atomic_fetch_add(ctr, 1u, RLX_AGENT);
        __syncthreads();
        const int j = *nxt; if (j >= 512) break;
        const int qb = 15 - (j >> 5), kind = ((j >> 4) & 1) ^ 1, bh = j & 15, b = bh >> 3, h = bh & 7;
        const size_t hoff = (size_t)(b * NH + h) * SEQ * HD;
        const f16* Q = qkv + (size_t)(kind * 3 + 0) * QKV_ONE + hoff; const f16* K = qkv + (size_t)(kind * 3 + 1) * QKV_ONE + hoff; const f16* V = qkv + (size_t)(kind * 3 + 2) * QKV_ONE + hoff;
        f16* O = Obase + (size_t)kind * QKV_ONE + (size_t)b * SEQ * AW + h * HD;
        att::BlockRef r;
        r.Q = Q + (size_t)qb * 256 * HD; r.K = K; r.V = V; r.O = O + (size_t)qb * 256 * AW; r.P0 = qb * 256; r.M = mask + ((size_t)b * SEQ + qb * 256) * 64; r.sel = (const unsigned*)(lds + att::LDS_SELM);
        if (kind == 0) { moba_select(r.Q, km + ((size_t)(b * MOBA_NB) * NH + h) * HD, qb, selm, kml, tid); att::attn_block<0, true>(r, lds); }
        else { att::attn_block<1, true>(r, lds); }
    }
    asm volatile("s_waitcnt vmcnt(0)" ::: "memory"); __syncthreads();
}

__global__ void __launch_bounds__(NWAVES * 64, 2) mk_fwd(Args args) {
    extern __shared__ __attribute__((aligned(16))) unsigned char lds[];
    LAS unsigned char* ldsl = (LAS unsigned char*)lds;
    volatile LAS unsigned* MISC = (volatile LAS unsigned*)(ldsl + MISC_OFF);
    const int tid = threadIdx.x, lane = tid & 63, wave = __builtin_amdgcn_readfirstlane(tid >> 6);
    const int G = gridDim.x; int vcu; { const int bx = blockIdx.x; vcu = (G % 8 == 0) ? (bx % 8) * (G / 8) + bx / 8 : bx; }
    unsigned char* ws = args.ws;
    gu32* ctl = (gu32*)(ws + WS_CTL);
    for (int u = tid; u < (LDS_BYTES - LDSCTL_OFF) / 4; u += NWAVES * 64) ((LAS unsigned*)(ldsl + LDSCTL_OFF))[u] = 0u;
    __syncthreads();
    if (tid == 0) { LAS u64* pt = (LAS u64*)(ldsl + PTRTAB_OFF);
        pt[0] = (u64)args.in[0]; pt[1] = (u64)args.in[3]; pt[2] = (u64)args.in[5]; pt[3] = (u64)args.in[10]; pt[4] = (u64)args.in[11]; pt[5] = (u64)args.out; pt[6] = (u64)args.ws;
        pt[7] = (u64)args.in[6]; pt[8] = (u64)args.in[7]; pt[9] = (u64)args.in[8]; pt[10] = (u64)args.in[9]; pt[11] = (u64)args.in[12]; pt[12] = (u64)args.in[13]; }
    __syncthreads();
    XcdBarrier bar; bar.bar = (unsigned*)(ctl + CW_BAR); bar.x = 0; bar.st = nullptr;
    if (MK_N_LAUNCHES == 1) bar = xcd_barrier_post((unsigned*)(ctl + CW_BAR), MISC + 8);
    const int lo = args.ph_lo, hi = args.ph_hi;
#define IN(k) (lo <= (k) && (k) < hi)
#define SEAM(k) do { if (IN(k) && IN((k) + 1)) xcd_barrier(bar); } while (0)
    if (IN(0)) { p0_prologue(args, ldsl, vcu, G, wave, lane, tid); } SEAM(0);
    if (IN(1)) { p1_norm_in(args, ldsl, vcu, G, wave, lane, tid); } SEAM(1);
    if (IN(2)) {
        { pg8::Gemm g{(const f16*)(ws + WS_H), (const f16*)(ws + WS_WIN), nullptr, nullptr, DM};
          pg8::StaticOrder S; S.init(MTOK, N_IN16, G, (int)blockIdx.x);
          pg8::EpiIn E{(f16*)(ws + WS_QKV), (f16*)(ws + WS_QIDX), (f16*)(ws + WS_KIDX), (float*)(ws + WS_WIDX), (f16*)(ws + WS_GA), (f16*)(ws + WS_GB), (const float*)(ws + WS_ROPEA), (const float*)(ws + WS_ROPEB), 0};
          pg8::gemm_phase<pg8::EpiIn, pg8::StaticOrder, true>(ldsl, g, S, E); }
        { pg8::Gemm g{(const f16*)(ws + WS_H8), (const f16*)(ws + WS_WG8), nullptr, nullptr, DM};
          pg8::StaticOrder S; S.init(MTOK, N_IN8, G, (int)blockIdx.x);
          pg8::EpiIn E{(f16*)(ws + WS_QKV), (f16*)(ws + WS_QIDX), (f16*)(ws + WS_KIDX), (float*)(ws + WS_WIDX), (f16*)(ws + WS_GA), (f16*)(ws + WS_GB), (const float*)(ws + WS_ROPEA), (const float*)(ws + WS_ROPEB), 1};
          pg8::gemm_phase<pg8::EpiIn, pg8::StaticOrder, true, true, 0x7F7F7F7F, 0x77777777, true>(ldsl, g, S, E); }
        if (CONV_SPLIT < CONV_TOTAL) {
            const int rem = ((MTOK / 256) * (N_IN16 / 256)) % G, wi = rem ? (int)blockIdx.x - rem : (int)blockIdx.x, nw = rem ? G - rem : G;
            if (wi >= 0) conv_items(ws, ldptr(ldsl, 7), ldptr(ldsl, 8), ldptr(ldsl, 9), ldptr(ldsl, 10), ldptr(ldsl, 11), ldptr(ldsl, 12), ldsl, CONV_SPLIT, CONV_TOTAL, wi * NWAVES + wave, nw * NWAVES, wave, lane); }
    } SEAM(2);
    if (IN(3)) { p3_indexer(args, ldsl, vcu, G, wave, lane, tid); } SEAM(3);
    if (IN(4)) { p4_attention(args, ldsl, (char*)lds, vcu, G, tid); } SEAM(4);
    if (IN(5)) {
        pg8::Gemm g{(const f16*)(ws + WS_H), (const f16*)(ws + WS_WMO), (const f16*)(ws + WS_H) + QKV_ONE, (const f16*)(ws + WS_WDO), AW};
        pg8::StaticOrder S; S.init(MTOK, DM, G, (int)blockIdx.x, 2);
        pg8::EpiOut E{(const f16*)(ws + WS_GA), (const f16*)(ws + WS_GB), (unsigned char*)(ws + WS_QKV)};
        pg8::gemm_phase<pg8::EpiOut, pg8::StaticOrder, true>(ldsl, g, S, E);
    } SEAM(5);
    if (IN(6)) {
        pg8::Gemm g{(const f16*)(ws + WS_QKV), (const f16*)(ws + WS_WO), nullptr, nullptr, DM};
        pg8::StaticOrder S; S.init(MTOK, DM, G, (int)blockIdx.x);
        pg8::EpiSq E{(f16*)(ws + WS_QKV + 32 * MiB), (float*)(ws + WS_SSP1)};
        pg8::gemm_phase<pg8::EpiSq, pg8::StaticOrder, false, true, 0x7B7B7B7B, 0x77777777, true>(ldsl, g, S, E);
    } SEAM(6);
    if (IN(7)) { int t2 = threadIdx.x; asm volatile("" : "+v"(t2)); p7_mid(args, ldsl, vcu, G, __builtin_amdgcn_readfirstlane(t2 >> 6), t2 & 63, t2); } SEAM(7);
    if (IN(8)) {
        pg8::Gemm g{(const f16*)(ws + WS_H), (const f16*)(ws + WS_W1), nullptr, nullptr, DM};
        pg8::StaticOrder S; S.init(MTOK, FF, G, (int)blockIdx.x);
        pg8::EpiRelu2 E{(unsigned char*)(ws + WS_U)};
        pg8::gemm_phase<pg8::EpiRelu2, pg8::StaticOrder, true, false, 0x7F7F7F7F, 0x7F7F7F7F, true>(ldsl, g, S, E);
    } SEAM(8);
    if (IN(9)) {
        pg8::Gemm g{(const f16*)(ws + WS_U), (const f16*)(ws + WS_W2), nullptr, nullptr, FF};
        pg8::StaticOrder S; S.init(MTOK, DM, G, (int)blockIdx.x);
        pg8::EpiSq E{(f16*)(ws + WS_F), (float*)(ws + WS_SSP2)};
        pg8::gemm_phase<pg8::EpiSq, pg8::StaticOrder, false, true, 0x7F7F7F7F, 0x77777777, true>(ldsl, g, S, E);
    } SEAM(9);
    if (IN(10)) { int t2 = threadIdx.x; asm volatile("" : "+v"(t2)); p10_final(args, ldsl, vcu, G, __builtin_amdgcn_readfirstlane(t2 >> 6), t2 & 63, t2); }
#undef IN
#undef SEAM
}

extern "C" void kernel_launch(void* const* d_in, const int* in_sizes, int n_in, void* d_out, int out_size, void* d_ws, size_t ws_size, hipStream_t stream) {
    static int grid = 0;
    if (grid == 0) {
        if (n_in != 14 || out_size != MTOK * DM || ws_size < WS_END) { fprintf(stderr, "kernel_launch: unexpected shapes (n_in %d out %d ws %zu)\n", n_in, out_size, ws_size); grid = -1; return; }
        int dev = 0, cus = 0;
        if (hipGetDevice(&dev) != hipSuccess || hipDeviceGetAttribute(&cus, hipDeviceAttributeMultiprocessorCount, dev) != hipSuccess) { grid = -1; return; }
        if (hipFuncSetAttribute((const void*)mk_fwd, hipFuncAttributeMaxDynamicSharedMemorySize, LDS_BYTES) != hipSuccess) { fprintf(stderr, "kernel_launch: hipFuncSetAttribute failed\n"); grid = -1; return; }
        int per_cu = 0;
        if (hipOccupancyMaxActiveBlocksPerMultiprocessor(&per_cu, (const void*)mk_fwd, NWAVES * 64, LDS_BYTES) != hipSuccess || per_cu < 1) { fprintf(stderr, "kernel_launch: occupancy query says %d\n", per_cu); }
        (void)hipGetLastError();
        grid = cus;
    }
    if (grid < 0) return;
    (void)hipMemsetAsync((char*)d_ws + WS_CTL, 0, CTL_ZERO_BYTES, stream);
    Args a{};
    for (int i = 0; i < 14; ++i) a.in[i] = (const float*)d_in[i];
    a.out = (float*)d_out; a.ws = (unsigned char*)d_ws;
    if (MK_N_LAUNCHES == 1) {
        a.ph_lo = 0; a.ph_hi = NPHASE;
        hipLaunchKernelGGL(mk_fwd, dim3(grid), dim3(NWAVES * 64), LDS_BYTES, stream, a);
    } else {
        for (int p = 0; p < NPHASE; ++p) { a.ph_lo = p; a.ph_hi = p + 1;
            for (int r = 0; r < (((MK_DOUBLE_MASK >> p) & 1) ? 2 : 1); ++r) hipLaunchKernelGGL(mk_fwd, dim3(grid), dim3(NWAVES * 64), LDS_BYTES, stream, a); }
    }
}
```

```cpp
#include <hip/hip_runtime.h>
#include <cstdio>
#include <cstdint>

#ifndef MK_N_LAUNCHES
#define MK_N_LAUNCHES 1
#endif

#ifndef MK_DOUBLE_MASK
#define MK_DOUBLE_MASK 0
#endif
#define LAS __attribute__((address_space(3)))
#define GAS __attribute__((address_space(1)))
typedef _Float16 f16;
typedef _Float16 f16x8 __attribute__((ext_vector_type(8)));
typedef _Float16 f16x4 __attribute__((ext_vector_type(4)));
typedef _Float16 f16x2 __attribute__((ext_vector_type(2)));
typedef float f32x2 __attribute__((ext_vector_type(2)));
typedef float f32x4 __attribute__((ext_vector_type(4)));
typedef float f32x16 __attribute__((ext_vector_type(16)));
typedef unsigned u32x2 __attribute__((ext_vector_type(2)));
typedef unsigned u32x4 __attribute__((ext_vector_type(4)));
typedef int i32x4 __attribute__((ext_vector_type(4)));
typedef int i32x8 __attribute__((ext_vector_type(8)));
typedef short s16x4 __attribute__((ext_vector_type(4)));
typedef unsigned long long u64;

constexpr int BATCH = 2, SEQ = 4096, DM = 2048, MTOK = BATCH * SEQ, NH = 8, HD = 128, AW = NH * HD, FF = 8192;
constexpr int IDXH = 16, IDXD = 64, DSA_TOPK = 256, MOBA_BLOCK = 256, MOBA_NB = SEQ / MOBA_BLOCK, MOBA_TOPK = 3;
constexpr int D_IN = 11344, N_IN_PAD = 11520;
constexpr int N_IN16 = 21 * 256, N_IN8 = 24 * 256;
constexpr int C_QI = 6144, C_KI = 7168, C_WI = 7232, C_GA = 7248, C_GB = 9296;
constexpr float RMS_EPS = 1e-6f;

constexpr size_t MiB = 1u << 20;
constexpr size_t WS_CTL = 0, CTL_ZERO_BYTES = 64 * 1024;
constexpr size_t WS_KMEAN = 1 * MiB;
constexpr size_t WS_MODF = 1 * MiB + 256 * 1024;
constexpr size_t WS_MODP = 2 * MiB;
constexpr size_t WS_SSP1 = 5 * MiB, WS_SSP2 = 6 * MiB;
constexpr size_t WS_ROPEA = 7 * MiB;
constexpr size_t WS_ROPEB = 9 * MiB;
constexpr size_t WS_WIDX = 10 * MiB;
constexpr size_t WS_KIDX = 10 * MiB + 512 * 1024;
constexpr size_t WS_MASK = 12 * MiB;
constexpr size_t WS_WIN = 16 * MiB;
constexpr size_t WS_WMO = 61 * MiB, WS_WDO = 65 * MiB, WS_WO = 69 * MiB, WS_W1 = 77 * MiB, WS_W2 = 109 * MiB;
constexpr size_t WS_H = 141 * MiB;
constexpr size_t WS_QKV = 173 * MiB;
constexpr size_t WS_QIDX = 269 * MiB;
constexpr size_t WS_GA = 285 * MiB, WS_GB = 317 * MiB;
constexpr size_t WS_U = 173 * MiB;
constexpr size_t WS_F = 301 * MiB;
constexpr size_t WS_H8 = 125 * MiB;
constexpr size_t WS_WG8 = 349 * MiB;
constexpr size_t WS_END = 361 * MiB;
constexpr size_t QKV_ONE = (size_t)MTOK * AW;

constexpr int NPHASE = 11;

__device__ __forceinline__ unsigned pkh(float lo, float hi) { f32x2 v = {lo, hi}; f16x2 h = __builtin_convertvector(v, f16x2); return __builtin_bit_cast(unsigned, h); }
__device__ __forceinline__ f32x2 unpkh(unsigned w) { f16x2 h = __builtin_bit_cast(f16x2, w); return __builtin_convertvector(h, f32x2); }
__device__ __forceinline__ float wave_sum(float v) {
#pragma unroll
    for (int o = 1; o < 64; o <<= 1) v += __shfl_xor(v, o);
    return v;
}
__device__ __forceinline__ float sigmoidf_(float x) { return __builtin_amdgcn_rcpf(1.0f + __builtin_amdgcn_exp2f(-1.4426950408889634f * x)); }
#define LDS_WAIT() asm volatile("s_waitcnt lgkmcnt(0)" ::: "memory")
#define VM_WAIT() asm volatile("s_waitcnt vmcnt(0)" ::: "memory")

namespace pg8 {
constexpr int BM = 256, BK = 64, HALF = 128, HTB = HALF * BK * 2, STAGE_BYTES = 8 * HTB, NXCD = 8, WGM = 8;
__host__ __device__ __forceinline__ int lds_byte(int r, int c) { const int st = (r >> 4) * 2 + (c >> 5), rr = r & 15, cc = c & 31, ob = rr * 64 + cc * 2; return st * 1024 + (ob ^ (((ob >> 9) & 1) << 5)); }
__host__ __device__ __forceinline__ void stage_rc(int b, int& R, int& C) { const int st = b / 1024, sb = b % 1024, swz = sb ^ (((sb >> 9) & 1) << 5); R = (st >> 1) * 16 + swz / 64; C = (st & 1) * 32 + (swz % 64) / 2; }
__host__ __device__ __forceinline__ int perm32(int rho) { const int n = rho >> 4, i = rho & 15; return 8 * (i >> 2) + 4 * n + (i & 3); }

struct Unit { int pm, pn, z; };
struct Gemm { const f16* A0; const f16* B0; const f16* A1; const f16* B1; int K; };

struct StaticOrder {
    int nM, nN, nwg, G, c, nz;
    __device__ void init(int M, int N, int G_, int c_, int nz_ = 1) { nM = M / BM; nN = N / BM; nwg = nM * nN; G = G_; c = c_; nz = nz_; }
    __device__ bool next(int i, Unit& u) const {
        const int it = i / nz; u.z = i - it * nz;
        const long L = (long)it * G + c; if (L >= nwg) return false;
        int wgid = (int)L; { const int q = nwg / NXCD, r = nwg % NXCD, xcd = wgid % NXCD, off = wgid / NXCD; wgid = (xcd < r ? xcd * (q + 1) : r * (q + 1) + (xcd - r) * q) + off; }
        const int nig = WGM * nN, gid = wgid / nig, fm = gid * WGM, gsz = (nM - fm) < WGM ? (nM - fm) : WGM;
        u.pm = fm + ((wgid % nig) % gsz); u.pn = (wgid % nig) / gsz; return true;
    }
};

template <class Epi, class Sched, bool ALIGN_EPI, bool F8 = false, int SCL_A = 0x7F7F7F7F, int SCL_B = 0x7F7F7F7F, bool ZI = false>
__device__ __forceinline__ void gemm_phase(LAS unsigned char* lds, const Gemm g, const Sched& S, const Epi& E) {
    const int tid = threadIdx.x, wid = __builtin_amdgcn_readfirstlane(tid >> 6), lane = tid & 63, wr = wid >> 2, wc = wid & 3, fr = lane & 15, fq = lane >> 4;
    const int K = g.K, Kb = F8 ? K : 2 * K  , nt = Kb / (2 * BK);
    unsigned voffA[2], voffB[2], voffB1[2];
#pragma unroll
    for (int i = 0; i < 2; ++i) { int R, C; stage_rc(tid * 16 + i * 8192, R, C); const int Rb = (R & ~31) + perm32(R & 31);
        voffA[i] = (unsigned)(R * Kb + C * 2);
        if constexpr (Epi::PERM256) { const int wq = R >> 5, n_ = (R >> 4) & 1, i_ = R & 15, r0 = 64 * wq + 16 * (i_ >> 2) + 4 * n_ + (i_ & 3);
            voffB[i] = (unsigned)(r0 * Kb + C * 2); voffB1[i] = (unsigned)((r0 + 8) * Kb + C * 2); }
        else { voffB[i] = (unsigned)(Rb * Kb + C * 2); voffB1[i] = voffB[i] + (unsigned)(HALF * Kb); } }
    const size_t kstep = (size_t)(BK * 2);
    const size_t hstep = (size_t)HALF * Kb;
    const size_t tstep = 2 * hstep;
    const unsigned ldsw = (unsigned)wid * 1024u;
    const int aoff = lds_byte(wr * 64 + fr, F8 ? fq * 16 : fq * 8), boff = lds_byte(wc * 32 + fr, F8 ? fq * 16 : fq * 8);
#define PG8_SA(b, h) (((b) * 2 + (h)) * HTB)
#define PG8_SB(b, h) ((4 + (b) * 2 + (h)) * HTB)
#define PG8_STAGE(bufoff, gbase, voff) do { _Pragma("unroll") for (int _i = 0; _i < 2; ++_i) \
        __builtin_amdgcn_global_load_lds((const unsigned*)((const char*)(gbase) + (voff)[_i]), (LAS unsigned*)(lds + (bufoff) + ldsw + _i * 8192), 16, 0, 0); } while (0)
#define PG8_KOFF(k) (F8 ? (k) * 16 : (k) * 1024)
#define PG8_LDA(dst, b, h) do { _Pragma("unroll") for (int m = 0; m < 4; ++m) _Pragma("unroll") for (int k = 0; k < 2; ++k) dst[m][k] = *(const LAS f16x8*)(lds + PG8_SA(b, h) + aoff + m * 2048 + PG8_KOFF(k)); } while (0)
#define PG8_LDB(dst, b, h) do { _Pragma("unroll") for (int n = 0; n < 2; ++n) _Pragma("unroll") for (int k = 0; k < 2; ++k) dst[n][k] = *(const LAS f16x8*)(lds + PG8_SB(b, h) + boff + n * 2048 + PG8_KOFF(k)); } while (0)
#define PG8_F8(x) __builtin_shufflevector(__builtin_bit_cast(i32x4, x[0]), __builtin_bit_cast(i32x4, x[1]), 0, 1, 2, 3, 4, 5, 6, 7)
      \
#define PG8_MMA(ai, bj, At, Bt, Z) do { __builtin_amdgcn_s_setprio(1); _Pragma("unroll") for (int m = 0; m < 4; ++m) _Pragma("unroll") for (int n = 0; n < 2; ++n) { \
        if constexpr (F8) { const i32x8 b8_ = PG8_F8(Bt[n]), a8_ = PG8_F8(At[m]);     \
            if constexpr (Z) asm volatile("v_mfma_scale_f32_16x16x128_f8f6f4 %0, %1, %2, 0, %3, %4 op_sel_hi:[0,0,0]" : "=&v"(acc[ai][bj][m][n]) : "v"(b8_), "v"(a8_), "v"(sclB_), "v"(sclA_)); \
            else asm volatile("v_mfma_scale_f32_16x16x128_f8f6f4 %0, %1, %2, %0, %3, %4 op_sel_hi:[0,0,0]" : "+v"(acc[ai][bj][m][n]) : "v"(b8_), "v"(a8_), "v"(sclB_), "v"(sclA_)); } \
        else { if constexpr (Z) acc[ai][bj][m][n] = __builtin_amdgcn_mfma_f32_16x16x32_f16(Bt[n][0], At[m][0], (f32x4){0.f, 0.f, 0.f, 0.f}, 0, 0, 0); \
               else acc[ai][bj][m][n] = __builtin_amdgcn_mfma_f32_16x16x32_f16(Bt[n][0], At[m][0], acc[ai][bj][m][n], 0, 0, 0); \
               acc[ai][bj][m][n] = __builtin_amdgcn_mfma_f32_16x16x32_f16(Bt[n][1], At[m][1], acc[ai][bj][m][n], 0, 0, 0); } } \
        __builtin_amdgcn_s_setprio(0); } while (0)
#define PG8_WAIT_V(n) asm volatile("s_waitcnt vmcnt(" #n ")" ::: "memory")
#define PG8_WAIT_L(n) asm volatile("s_waitcnt lgkmcnt(" #n ")" ::: "memory")
#define PG8_BAR __builtin_amdgcn_s_barrier()
#define PG8_SCHED __builtin_amdgcn_sched_barrier(0)
    constexpr bool ZINIT = ZI && !Epi::KEEPS;
    Unit cur, nxt; int ui = 0;
    if (!S.next(0, cur)) return;
    f32x4 acc[2][2][4][2];
#pragma unroll
    for (int a = 0; a < 2; ++a)
#pragma unroll
        for (int b = 0; b < 2; ++b)
#pragma unroll
            for (int m = 0; m < 4; ++m)
#pragma unroll
                for (int n = 0; n < 2; ++n) acc[a][b][m][n] = (f32x4){0.f, 0.f, 0.f, 0.f};
    f16x8 At[4][2], B0[2][2], B1[2][2];
    const int sclA_ = SCL_A, sclB_ = SCL_B; (void)sclA_; (void)sclB_;
    const char* cA = (const char*)(cur.z ? g.A1 : g.A0) + (size_t)cur.pm * tstep; const char* cB = (const char*)(cur.z ? g.B1 : g.B0) + (size_t)cur.pn * tstep;
    PG8_STAGE(PG8_SB(0, 0), cB, voffB); PG8_STAGE(PG8_SB(0, 1), cB, voffB1); PG8_STAGE(PG8_SA(0, 0), cA, voffA); PG8_STAGE(PG8_SA(0, 1), cA + hstep, voffA);
    if (wr == 1) PG8_BAR;
    PG8_WAIT_V(2); PG8_BAR;
    PG8_STAGE(PG8_SB(1, 0), cB + kstep, voffB); PG8_STAGE(PG8_SA(1, 0), cA + kstep, voffA); PG8_STAGE(PG8_SB(1, 1), cB + kstep, voffB1);
    PG8_WAIT_V(6); PG8_BAR;
    for (;;) {
        const bool has_next = S.next(ui + 1, nxt);
        const char* nA = has_next ? (const char*)(nxt.z ? g.A1 : g.A0) + (size_t)nxt.pm * tstep : cA; const char* nB = has_next ? (const char*)(nxt.z ? g.B1 : g.B0) + (size_t)nxt.pn * tstep : cB;
#define PG8_BODY(Z) do { \
            const bool last = (t == nt - 2); \
            const char* a1 = cA + (size_t)(t + 1) * kstep; \
            const char* a2 = last ? nA : cA + (size_t)(t + 2) * kstep; const char* b2 = last ? nB : cB + (size_t)(t + 2) * kstep; \
            const char* a3 = a2 + kstep; const char* b3 = b2 + kstep; \
            PG8_LDB(B0, 0, 0); PG8_LDB(B1, 0, 1); PG8_SCHED; PG8_LDA(At, 0, 0); PG8_STAGE(PG8_SA(1, 1), a1 + hstep, voffA); \
            PG8_WAIT_V(8); PG8_WAIT_L(0); PG8_BAR; PG8_MMA(0, 0, At, B0, Z); PG8_MMA(0, 1, At, B1, Z); PG8_BAR; PG8_SCHED; \
            PG8_LDA(At, 0, 1); PG8_STAGE(PG8_SB(0, 0), b2, voffB); PG8_STAGE(PG8_SB(0, 1), b2, voffB1); PG8_STAGE(PG8_SA(0, 0), a2, voffA); \
            PG8_WAIT_V(8); PG8_WAIT_L(0); PG8_BAR; PG8_MMA(1, 0, At, B0, Z); PG8_MMA(1, 1, At, B1, Z); PG8_BAR; PG8_SCHED; \
            PG8_LDB(B0, 1, 0); PG8_LDB(B1, 1, 1); PG8_SCHED; PG8_LDA(At, 1, 0); PG8_STAGE(PG8_SA(0, 1), a2 + hstep, voffA); \
            PG8_WAIT_V(8); PG8_WAIT_L(0); PG8_BAR; PG8_MMA(0, 0, At, B0, false); PG8_MMA(0, 1, At, B1, false); PG8_BAR; PG8_SCHED; \
            PG8_LDA(At, 1, 1); PG8_STAGE(PG8_SB(1, 0), b3, voffB); PG8_STAGE(PG8_SB(1, 1), b3, voffB1); PG8_STAGE(PG8_SA(1, 0), a3, voffA); \
            PG8_WAIT_V(8); PG8_WAIT_L(0); PG8_BAR; PG8_MMA(1, 0, At, B0, false); PG8_MMA(1, 1, At, B1, false); PG8_BAR; PG8_SCHED; } while (0)
        if constexpr (ZINIT) { { const int t = 0; PG8_BODY(true); }
            for (int t = 2; t < nt; t += 2) PG8_BODY(false); }
        else { for (int t = 0; t < nt; t += 2) PG8_BODY(false); }
        if constexpr (ALIGN_EPI) { if (wr == 0) PG8_BAR; }
        if constexpr (F8) asm volatile("s_nop 15\n\ts_nop 15" ::: "memory");
        { int t2 = threadIdx.x; asm volatile("" : "+v"(t2));
          const int w2 = __builtin_amdgcn_readfirstlane(t2 >> 6), l2 = t2 & 63; E(acc, cur, w2 >> 2, w2 & 3, l2 & 15, l2 >> 4); }
        if (!has_next) break;
        if (!ZINIT && !E.keep(cur)) {
#pragma unroll
        for (int a = 0; a < 2; ++a)
#pragma unroll
            for (int b = 0; b < 2; ++b)
#pragma unroll
                for (int m = 0; m < 4; ++m)
#pragma unroll
                    for (int n = 0; n < 2; ++n) acc[a][b][m][n] = (f32x4){0.f, 0.f, 0.f, 0.f};
        }
        cur = nxt; cA = nA; cB = nB; ++ui;
        if constexpr (ALIGN_EPI) { if (wr == 1) PG8_BAR; }
    }
    PG8_WAIT_V(0);
    if constexpr (!ALIGN_EPI) { if (wr == 0) PG8_BAR; }
    PG8_BAR;
#undef PG8_SA
#undef PG8_SB
#undef PG8_STAGE
#undef PG8_LDA
#undef PG8_LDB
#undef PG8_MMA
#undef PG8_BODY
#undef PG8_F8
#undef PG8_KOFF
#undef PG8_WAIT_V
#undef PG8_WAIT_L
#undef PG8_BAR
#undef PG8_SCHED
}

typedef f32x4 AccT[2][2][4][2];
__device__ __forceinline__ void st8h(f16* p, const f32x4& a, const f32x4& b) { u32x4 w; w.x = pkh(a[0], a[1]); w.y = pkh(a[2], a[3]); w.z = pkh(b[0], b[1]); w.w = pkh(b[2], b[3]); *(u32x4*)p = w; }

struct EpiIn {
    static constexpr bool PERM256 = false, KEEPS = false;
    f16* qkv; f16* qidx; f16* kidx; float* widx; f16* ga; f16* gb; const float* ropeA; const float* ropeB; int mode;
    __device__ __forceinline__ bool keep(const Unit&) const { return false; }
    static __device__ __forceinline__ void rope8(const f32x4& a0, const f32x4& a1, const f32x4& b0, const f32x4& b1, const f32x4& c0, const f32x4& c1, const f32x4& c2, const f32x4& c3, f16* dlo, f16* dhi) {
        const f32x4 o1a = a0 * c0 - b0 * c1, o2a = b0 * c0 + a0 * c1, o1b = a1 * c2 - b1 * c3, o2b = b1 * c2 + a1 * c3;
        st8h(dlo, o1a, o1b); st8h(dhi, o2a, o2b);
    }
    template <class F>
    static __device__ __forceinline__ void rope_tile(AccT& acc, int row0, const float* tab, int tw, int dlo, int hoff, F dstf) {
        f32x4 cs[2][2][4];
#define ROPE_LD(q_, buf_) do { _Pragma("unroll") for (int mm = 0; mm < 2; ++mm) { const int t = (row0 + ((q_) >> 1) * HALF + (((q_) & 1) * 2 + mm) * 16) & (SEQ - 1); const float* cp = tab + ((size_t)t * tw + dlo) * 2; \
            _Pragma("unroll") for (int i = 0; i < 4; ++i) cs[buf_][mm][i] = *(const f32x4*)(cp + 4 * i); } } while (0)
#define ROPE_DO(q_, buf_) do { _Pragma("unroll") for (int mm = 0; mm < 2; ++mm) { const int ai = (q_) >> 1, m = ((q_) & 1) * 2 + mm; f16* dst = dstf(row0 + ai * HALF + m * 16); \
            rope8(acc[ai][0][m][0], acc[ai][0][m][1], acc[ai][1][m][0], acc[ai][1][m][1], cs[buf_][mm][0], cs[buf_][mm][1], cs[buf_][mm][2], cs[buf_][mm][3], dst, dst + hoff); } } while (0)
        ROPE_LD(0, 0); ROPE_LD(1, 1); ROPE_DO(0, 0); ROPE_LD(2, 0); ROPE_DO(1, 1); ROPE_LD(3, 1); ROPE_DO(2, 0); ROPE_DO(3, 1);
#undef ROPE_LD
#undef ROPE_DO
    }
    __device__ __forceinline__ void operator()(AccT& acc, const Unit& u, int wr, int wc, int fr, int fq) const {
        const int p_ = u.pn; const int pn = mode == 0 ? (p_ < 8 ? p_ : (p_ < 16 ? p_ + 4 : p_ + 8)) : (p_ < 4 ? 8 + p_ : (p_ < 8 ? 16 + p_ : 21 + p_));
        const int row0 = u.pm * BM + wr * 64 + fr;
        if (pn < 24) {
            const int kind6 = pn >> 2, hp = pn & 3; f16* base = qkv + (size_t)kind6 * QKV_ONE;
            if ((kind6 % 3) != 2) {
                const int head = 2 * hp + (wc >> 1), dlo = 32 * (wc & 1) + 8 * fq;
                rope_tile(acc, row0, ropeA, 64, dlo, 64, [&](int row) { const int b = row >> 12, t = row & (SEQ - 1); return base + ((size_t)(b * NH + head) * SEQ + t) * HD + dlo; });
            } else {
#pragma unroll
                for (int ai = 0; ai < 2; ++ai)
#pragma unroll
                    for (int m = 0; m < 4; ++m) { const int row = row0 + ai * HALF + m * 16, b = row >> 12, t = row & (SEQ - 1);
#pragma unroll
                        for (int bj = 0; bj < 2; ++bj) { f16* dst = base + ((size_t)(b * NH + 2 * hp + bj) * SEQ + t) * HD + 32 * wc + 8 * fq; st8h(dst, acc[ai][bj][m][0], acc[ai][bj][m][1]); } }
            }
        } else if (pn < 28) {
            const int head = 4 * (pn - 24) + wc, dlo = 8 * fq;
            rope_tile(acc, row0, ropeB, 32, dlo, 32, [&](int row) { return qidx + (size_t)row * (IDXH * IDXD) + head * IDXD + dlo; });
        } else if (pn == 28) {
            if (wc == 0) {
                const int dlo = 8 * fq;
                rope_tile(acc, row0, ropeB, 32, dlo, 32, [&](int row) { return kidx + (size_t)row * IDXD + dlo; });
            } else if (wc == 1 && fq < 2) {
#pragma unroll
                for (int ai = 0; ai < 2; ++ai)
#pragma unroll
                    for (int m = 0; m < 4; ++m) { const int row = row0 + ai * HALF + m * 16; float* dst = widx + (size_t)row * IDXH + 8 * fq;
                        *(f32x4*)dst = acc[ai][0][m][0]; *(f32x4*)(dst + 4) = acc[ai][0][m][1]; }
            }
        } else {
            f16* gp = pn < 37 ? ga : gb; const int ct = (pn < 37 ? pn - 29 : pn - 37) * BM + 32 * wc + 8 * fq;
#pragma unroll
            for (int ai = 0; ai < 2; ++ai)
#pragma unroll
                for (int m = 0; m < 4; ++m) { const int row = row0 + ai * HALF + m * 16;
#pragma unroll
                    for (int bj = 0; bj < 2; ++bj) { f32x4 a = acc[ai][bj][m][0], b = acc[ai][bj][m][1];
#pragma unroll
                        for (int e = 0; e < 4; ++e) { a[e] = sigmoidf_(a[e]); b[e] = sigmoidf_(b[e]); }
                        st8h(gp + (size_t)row * DM + ct + bj * HALF, a, b); } }
        }
    }
};
struct EpiOut {
    static constexpr bool PERM256 = true, KEEPS = true;
    const f16* ga; const f16* gb; unsigned char* y;
    __device__ __forceinline__ bool keep(const Unit& u) const { return u.z == 0; }
    __device__ __forceinline__ void operator()(AccT& acc, const Unit& u, int wr, int wc, int fr, int fq) const {
        const int row0 = u.pm * BM + wr * 64 + fr, col0 = u.pn * BM + 64 * wc + 16 * fq;
#pragma unroll
        for (int ai = 0; ai < 2; ++ai) {
            u32x4 wbv[4][2], wav[4][2];
#pragma unroll
            for (int m = 0; m < 4; ++m)
#pragma unroll
                for (int bj = 0; bj < 2; ++bj) { const size_t off = (size_t)(row0 + ai * HALF + m * 16) * DM + col0 + bj * 8;
                    wbv[m][bj] = *(const u32x4*)(gb + off); if (u.z == 0) wav[m][bj] = *(const u32x4*)(ga + off); }
#pragma unroll
            for (int m = 0; m < 4; ++m) { const size_t off = (size_t)(row0 + ai * HALF + m * 16) * DM + col0; u32x4 ow;
#pragma unroll
                for (int bj = 0; bj < 2; ++bj) {
                    const u32x4 wb = wbv[m][bj];
                    const f32x2 b0 = unpkh(wb.x), b1 = unpkh(wb.y), b2 = unpkh(wb.z), b3 = unpkh(wb.w);
                    if (u.z == 0) {
                        const u32x4 wa = wav[m][bj];
                        const f32x2 a0 = unpkh(wa.x), a1 = unpkh(wa.y), a2 = unpkh(wa.z), a3 = unpkh(wa.w);
                        f32x4& x = acc[ai][bj][m][0]; f32x4& w = acc[ai][bj][m][1];
                        x[0] *= a0.x * __builtin_amdgcn_rcpf(b0.x); x[1] *= a0.y * __builtin_amdgcn_rcpf(b0.y); x[2] *= a1.x * __builtin_amdgcn_rcpf(b1.x); x[3] *= a1.y * __builtin_amdgcn_rcpf(b1.y);
                        w[0] *= a2.x * __builtin_amdgcn_rcpf(b2.x); w[1] *= a2.y * __builtin_amdgcn_rcpf(b2.y); w[2] *= a3.x * __builtin_amdgcn_rcpf(b3.x); w[3] *= a3.y * __builtin_amdgcn_rcpf(b3.y);
                    } else {
                        f32x4 x = acc[ai][bj][m][0], w = acc[ai][bj][m][1];
                        x[0] *= b0.x; x[1] *= b0.y; x[2] *= b1.x; x[3] *= b1.y; w[0] *= b2.x; w[1] *= b2.y; w[2] *= b3.x; w[3] *= b3.y;
#pragma unroll
                        for (int e = 0; e < 4; ++e) { x[e] = __builtin_amdgcn_fmed3f(x[e] * 16.f, -448.f, 448.f); w[e] = __builtin_amdgcn_fmed3f(w[e] * 16.f, -448.f, 448.f); }
                        int w0 = 0, w1 = 0;
                        w0 = __builtin_amdgcn_cvt_pk_fp8_f32(x[0], x[1], w0, false); w0 = __builtin_amdgcn_cvt_pk_fp8_f32(x[2], x[3], w0, true);
                        w1 = __builtin_amdgcn_cvt_pk_fp8_f32(w[0], w[1], w1, false); w1 = __builtin_amdgcn_cvt_pk_fp8_f32(w[2], w[3], w1, true);
                        if (bj == 0) { ow.x = (unsigned)w0; ow.y = (unsigned)w1; } else { ow.z = (unsigned)w0; ow.w = (unsigned)w1; }
                    }
                }
                if (u.z != 0) *(u32x4*)(y + off) = ow; }
        }
    }
};
struct EpiSq {
    static constexpr bool PERM256 = false, KEEPS = false;
    f16* out; float* ssp;
    __device__ __forceinline__ bool keep(const Unit&) const { return false; }
    __device__ __forceinline__ void operator()(AccT& acc, const Unit& u, int wr, int wc, int fr, int fq) const {
        const int row0 = u.pm * BM + wr * 64 + fr, col0 = u.pn * BM + 32 * wc + 8 * fq;
#pragma unroll
        for (int ai = 0; ai < 2; ++ai)
#pragma unroll
            for (int m = 0; m < 4; ++m) { const int row = row0 + ai * HALF + m * 16; float s = 0.f;
#pragma unroll
                for (int bj = 0; bj < 2; ++bj) { const f32x4 a = acc[ai][bj][m][0], b = acc[ai][bj][m][1];
                    s += (a[0] * a[0] + a[1] * a[1]) + (a[2] * a[2] + a[3] * a[3]) + (b[0] * b[0] + b[1] * b[1]) + (b[2] * b[2] + b[3] * b[3]);
                    st8h(out + (size_t)row * DM + col0 + bj * HALF, a, b); }
                s += __shfl_xor(s, 16); s += __shfl_xor(s, 32);
                if (fq == 0) ssp[(size_t)row * 32 + u.pn * 4 + wc] = s; }
    }
};
struct EpiRelu2 {
    static constexpr bool PERM256 = true, KEEPS = false;
    unsigned char* out;
    __device__ __forceinline__ bool keep(const Unit&) const { return false; }
    __device__ __forceinline__ void operator()(AccT& acc, const Unit& u, int wr, int wc, int fr, int fq) const {
        const int row0 = u.pm * BM + wr * 64 + fr, col0 = u.pn * BM + 64 * wc + 16 * fq;
#pragma unroll
        for (int ai = 0; ai < 2; ++ai)
#pragma unroll
            for (int m = 0; m < 4; ++m) { const int row = row0 + ai * HALF + m * 16; u32x4 ow;
#pragma unroll
                for (int bj = 0; bj < 2; ++bj) { f32x4 a = acc[ai][bj][m][0], b = acc[ai][bj][m][1];
#pragma unroll
                    for (int e = 0; e < 4; ++e) { const float x = __builtin_amdgcn_fmed3f(a[e], 0.f, 21.16601f), y = __builtin_amdgcn_fmed3f(b[e], 0.f, 21.16601f); a[e] = x * x; b[e] = y * y; }
                    int w0 = 0, w1 = 0;
                    w0 = __builtin_amdgcn_cvt_pk_fp8_f32(a[0], a[1], w0, false); w0 = __builtin_amdgcn_cvt_pk_fp8_f32(a[2], a[3], w0, true);
                    w1 = __builtin_amdgcn_cvt_pk_fp8_f32(b[0], b[1], w1, false); w1 = __builtin_amdgcn_cvt_pk_fp8_f32(b[2], b[3], w1, true);
                    if (bj == 0) { ow.x = (unsigned)w0; ow.y = (unsigned)w1; } else { ow.z = (unsigned)w0; ow.w = (unsigned)w1; } }
                *(u32x4*)(out + (size_t)row * FF + col0) = ow; }
    }
};
}

namespace att {
constexpr int D = 128, NW = 8, QBLK = 32, KVBLK = 64, QB = NW * QBLK;
constexpr int SHM_V = KVBLK * D * 2, SHM_K = KVBLK * D * 2;
constexpr int LDS_SELM = 2 * SHM_V + 2 * SHM_K + NW * 64 * 4;
constexpr int LDS_KM = LDS_SELM + 2 * 256 * 4;
constexpr int LDS_Q = 79872;
constexpr float SCALE = 0.08838834764831845f, THR = 8.f;
#define KSWZ(row, colB) ((row) * 256 + ((colB) ^ (((row) & 7) << 4)))
#define SBAR() __builtin_amdgcn_sched_barrier(0)
__device__ __forceinline__ int v_st(int k, int c) { const int kk = (k & ~0xC) | ((k & 4) << 1) | ((k & 8) >> 1); return ((kk >> 3) * 4 + (c >> 5)) * 512 + ((kk & 7) * 32 + (c & 31)) * 2; }
__device__ __forceinline__ int v_rd_base(int lane) { return ((lane & 3) << 3) | (((lane >> 2) & 3) << 6) | (((lane >> 4) & 1) << 5) | (((lane >> 5) & 1) << 8); }
constexpr int v_rd_off(int d0, int ks, int half) { return d0 * 512 + ks * 4096 + half * 2048; }
__device__ __forceinline__ int crow(int r, int hi) { return (r & 3) + 8 * (r >> 2) + 4 * hi; }
__device__ __forceinline__ f16x8 load8(const f16* p) { return *reinterpret_cast<const f16x8*>(p); }
__device__ __forceinline__ void mask_causal(f32x16& p0, f32x16& p1, int dq) {
    const float NEG = -__builtin_inff();
#pragma unroll
    for (int r = 0; r < 16; ++r) { const int c = (r & 3) + 8 * (r >> 2); if (dq - c < 0) p0[r] = NEG; if (dq - c - 32 < 0) p1[r] = NEG; }
}
__device__ __forceinline__ void mask_bits(f32x16& p0, f32x16& p1, unsigned w0, unsigned w1) {
#pragma unroll
    for (int r = 0; r < 16; ++r) { const int c = (r & 3) + 8 * (r >> 2);
        const unsigned m0 = (unsigned)__builtin_amdgcn_sbfe((int)w0, c, 1), m1 = (unsigned)__builtin_amdgcn_sbfe((int)w1, c, 1);
        p0[r] = __uint_as_float((__float_as_uint(p0[r]) & m0) | (~m0 & 0xFF800000u));
        p1[r] = __uint_as_float((__float_as_uint(p1[r]) & m1) | (~m1 & 0xFF800000u)); }
}
__device__ __forceinline__ float sm_max(const f32x16& p0, const f32x16& p1) {
    float pmax, pmb;
    asm("v_max3_f32 %0, %1, %2, %3" : "=v"(pmax) : "v"(p0[0]), "v"(p0[1]), "v"(p0[2])); asm("v_max3_f32 %0, %1, %2, %3" : "=v"(pmb) : "v"(p1[0]), "v"(p1[1]), "v"(p1[2]));
#pragma unroll
    for (int r = 3; r < 15; r += 2) { asm("v_max3_f32 %0, %0, %1, %2" : "+v"(pmax) : "v"(p0[r]), "v"(p0[r + 1])); asm("v_max3_f32 %0, %0, %1, %2" : "+v"(pmb) : "v"(p1[r]), "v"(p1[r + 1])); }
    asm("v_max3_f32 %0, %0, %1, %2" : "+v"(pmax) : "v"(p0[15]), "v"(p1[15])); asm("v_max_f32 %0, %0, %1" : "+v"(pmax) : "v"(pmb));
    { auto rr = __builtin_amdgcn_permlane32_swap(__float_as_uint(pmax), __float_as_uint(pmax), false, false);
      float a_ = __uint_as_float(rr[0]), b_ = __uint_as_float(rr[1]); asm("v_max_f32 %0, %1, %2" : "=v"(pmax) : "v"(a_), "v"(b_)); }
    return pmax;
}
__device__ __forceinline__ float sm_decide(float pmax, float& m_reg, float& mn, float& alpha) {
    constexpr float C2 = 1.4426950408889634f * SCALE;
    if (__builtin_expect(__all((pmax - m_reg) * SCALE <= THR), 1)) { mn = m_reg; alpha = 1.f; }
    else { mn = fmaxf(m_reg, pmax); alpha = __builtin_amdgcn_exp2f((m_reg - mn) * C2); m_reg = mn; }
    return -mn * C2;
}
__device__ __forceinline__ void sm_fma(f32x16& p, float mnL) { constexpr float C2 = 1.4426950408889634f * SCALE; for (int r = 0; r < 16; ++r) p[r] = fmaf(p[r], C2, mnL); }
__device__ __forceinline__ void sm_exp(f32x16& p) { for (int r = 0; r < 16; ++r) p[r] = __builtin_amdgcn_exp2f(p[r]); }
__device__ __forceinline__ void partialSM(f32x16& p0, f32x16& p1, float& m_reg, float& mn, float& alpha) {
    const float pmax = sm_max(p0, p1); const float mnL = sm_decide(pmax, m_reg, mn, alpha); sm_fma(p0, mnL); sm_fma(p1, mnL); sm_exp(p0);
}
__device__ __forceinline__ void finishSM(f32x16& p0, f32x16& p1, float alpha, float& l_reg, f16x8& pa0, f16x8& pa1, f16x8& pa2, f16x8& pa3) {
    for (int r = 0; r < 16; ++r) p1[r] = __builtin_amdgcn_exp2f(p1[r]);
    float ps = 0; for (int r = 0; r < 16; ++r) ps += p0[r]; for (int r = 0; r < 16; ++r) ps += p1[r];
    { auto rr = __builtin_amdgcn_permlane32_swap(__float_as_uint(ps), __float_as_uint(ps), false, false);
      ps = __uint_as_float(rr[0]) + __uint_as_float(rr[1]); }
    l_reg = l_reg * alpha + ps;
#define PK4(P, B_, OUT) do { unsigned a0 = pkh(P[B_+0], P[B_+1]), a1 = pkh(P[B_+2], P[B_+3]);                          \
        unsigned b0 = pkh(P[B_+4], P[B_+5]), b1 = pkh(P[B_+6], P[B_+7]);                                             \
        auto r0 = __builtin_amdgcn_permlane32_swap(a0, b0, false, false); auto r1 = __builtin_amdgcn_permlane32_swap(a1, b1, false, false); \
        u32x4 w = {r0[0], r1[0], r0[1], r1[1]}; OUT = *reinterpret_cast<f16x8*>(&w); } while (0)
    PK4(p0, 0, pa0); PK4(p0, 8, pa1); PK4(p1, 0, pa2); PK4(p1, 8, pa3);
#undef PK4
}
#define ATT_TRRD(dst, off) asm volatile("ds_read_b64_tr_b16 %0, %1 offset:%2" : "=&v"(dst) : "v"(vb0), "i"(off) : "memory")
#define ATT_MKV(l, h) __builtin_bit_cast(f16x8, (__attribute__((ext_vector_type(8))) short){l[0], l[1], l[2], l[3], h[0], h[1], h[2], h[3]})
#define ATT_PVG(VB, d0) do { s16x4 l0, l1, l2, l3, h0, h1, h2, h3; constexpr int b_ = (VB) * SHM_V + v_rd_off(d0, 0, 0); \
        ATT_TRRD(l0, b_); ATT_TRRD(h0, b_ + 2048); ATT_TRRD(l1, b_ + 4096); ATT_TRRD(h1, b_ + 6144); ATT_TRRD(l2, b_ + 8192); ATT_TRRD(h2, b_ + 10240); ATT_TRRD(l3, b_ + 12288); ATT_TRRD(h3, b_ + 14336); \
        asm volatile("s_waitcnt lgkmcnt(0)" ::: "memory"); SBAR();   \
        o[d0] = __builtin_amdgcn_mfma_f32_32x32x16_f16(pa0, ATT_MKV(l0, h0), o[d0], 0, 0, 0);   \
        o[d0] = __builtin_amdgcn_mfma_f32_32x32x16_f16(pa1, ATT_MKV(l1, h1), o[d0], 0, 0, 0);   \
        o[d0] = __builtin_amdgcn_mfma_f32_32x32x16_f16(pa2, ATT_MKV(l2, h2), o[d0], 0, 0, 0);   \
        o[d0] = __builtin_amdgcn_mfma_f32_32x32x16_f16(pa3, ATT_MKV(l3, h3), o[d0], 0, 0, 0); SBAR(); } while (0)
template <int VB>
__device__ __forceinline__ void pv_tile(f32x16* o, int vb0, f16x8 pa0, f16x8 pa1, f16x8 pa2, f16x8 pa3) {
#define TRRD(dst, off) asm volatile("ds_read_b64_tr_b16 %0, %1 offset:%2" : "=&v"(dst) : "v"(vb0), "i"(off) : "memory")
#define MKV(l, h) __builtin_bit_cast(f16x8, (__attribute__((ext_vector_type(8))) short){l[0], l[1], l[2], l[3], h[0], h[1], h[2], h[3]})
#define PV_D0(d0) do { s16x4 l0, l1, l2, l3, h0, h1, h2, h3; constexpr int b_ = VB * SHM_V + v_rd_off(d0, 0, 0); \
        TRRD(l0, b_); TRRD(h0, b_ + 2048); TRRD(l1, b_ + 4096); TRRD(h1, b_ + 6144); TRRD(l2, b_ + 8192); TRRD(h2, b_ + 10240); TRRD(l3, b_ + 12288); TRRD(h3, b_ + 14336); \
        asm volatile("s_waitcnt lgkmcnt(0)" ::: "memory"); SBAR();   \
        o[d0] = __builtin_amdgcn_mfma_f32_32x32x16_f16(pa0, MKV(l0, h0), o[d0], 0, 0, 0);   \
        o[d0] = __builtin_amdgcn_mfma_f32_32x32x16_f16(pa1, MKV(l1, h1), o[d0], 0, 0, 0);   \
        o[d0] = __builtin_amdgcn_mfma_f32_32x32x16_f16(pa2, MKV(l2, h2), o[d0], 0, 0, 0);   \
        o[d0] = __builtin_amdgcn_mfma_f32_32x32x16_f16(pa3, MKV(l3, h3), o[d0], 0, 0, 0); } while (0)
    PV_D0(0); PV_D0(1); PV_D0(2); PV_D0(3);
#undef PV_D0
#undef MKV
#undef TRRD
}
struct BlockRef { const f16* Q; const f16* K; const f16* V; f16* O; int P0; const u64* M; const unsigned* sel; };
#define ROW(p, k0, rr) ((p) + (size_t)((k0) + (rr)) * D + sc)
#define VMW() asm volatile("s_waitcnt vmcnt(0)" ::: "memory")
#define SLOAD_H(Kp, Vp, k0) do { st_v0 = load8(ROW(Vp, k0, sr)); st_v1 = load8(ROW(Vp, k0, 32 + sr));              \
                         st_k0 = load8(ROW(Kp, k0, sr)); st_k1 = load8(ROW(Kp, k0, 32 + sr)); } while (0)
#define SWRITE_HK(bf) do { *(f16x8*)(K_lds + (bf) * SHM_K + kws) = st_k0; *(f16x8*)(K_lds + (bf) * SHM_K + kws + 32 * 256) = st_k1; } while (0)
#define SWRITE_HV(bf) do { *(f16x8*)(V_lds + (bf) * SHM_V + vst0) = st_v0; *(f16x8*)(V_lds + (bf) * SHM_V + vst1) = st_v1; } while (0)
#define SWRITE_H(bf) do { SWRITE_HV(bf); SWRITE_HK(bf); } while (0)
template <int KB, bool QREG>
__device__ __forceinline__ void qkt(f32x16& p0, f32x16& p1, const char* K_lds, const char* Qw_lds, int r32, int hi, const f16x8* qr) {
    p0 = f32x16{}; p1 = f32x16{};
    int ko[4];
#pragma unroll
    for (int dd = 0; dd < 4; ++dd) ko[dd] = KSWZ(r32, (dd * 16 + hi * 8) * 2);
#pragma unroll
    for (int d0 = 0; d0 < 8; ++d0) { const char* a = K_lds + KB * SHM_K + ko[d0 & 3] + (d0 >> 2) * 128;
        f16x8 b0 = *reinterpret_cast<const f16x8*>(a);
        f16x8 b1 = *reinterpret_cast<const f16x8*>(a + 32 * 256);
        f16x8 qf = QREG ? qr[d0] : *reinterpret_cast<const f16x8*>(Qw_lds + ko[d0 & 3] + (d0 >> 2) * 128);
        p0 = __builtin_amdgcn_mfma_f32_32x32x16_f16(b0, qf, p0, 0, 0, 0);
        p1 = __builtin_amdgcn_mfma_f32_32x32x16_f16(b1, qf, p1, 0, 0, 0); }
}
template <int KIND, bool QREG>
__device__ __forceinline__ void attn_block(const BlockRef& cur, char* lds) {
    const int tid = threadIdx.x, wid = __builtin_amdgcn_readfirstlane(tid >> 6), lane = tid & 63, r32 = lane & 31, hi = lane >> 5;
    const int NT = (cur.P0 + QB) / KVBLK;
    const int qlo = cur.P0 + wid * QBLK, qm = qlo + r32 - 4 * hi;
    char* V_lds = lds; char* K_lds = lds + 2 * SHM_V; char* Qw_lds = lds + LDS_Q + wid * 8192;
    float* ws = (float*)(lds + 2 * SHM_V + 2 * SHM_K) + wid * 64; float* li_l = ws, * al_l = ws + 32;
    float m_reg = -1e30f, l_reg = 0; f32x16 o[4] = {};
    const int sr = tid >> 4, sc = (tid & 15) * 8, vst0 = v_st(sr, sc), vst1 = v_st(32 + sr, sc), kws = KSWZ(sr, sc * 2);
    const int vb0 = (int)(uintptr_t)V_lds + v_rd_base(lane);
    const f16* Kh = cur.K; const f16* Vh = cur.V;
    f16x8 st_v0, st_v1, st_k0, st_k1; f16x8 qr[8];
    unsigned selw = 0; const int moff = (wid * QBLK + r32) * 64; u64 mcur = 0;
    if constexpr (KIND == 0) { selw = cur.sel[wid * QBLK + r32]; }
#define MLOAD(t) do { if constexpr (KIND == 1) mcur = cur.M[moff + (t)]; } while (0)
#define RESC(a) do { if (__any((a) < 1.f)) { if (hi == 0) al_l[r32] = (a); asm volatile("s_waitcnt lgkmcnt(0)" ::: "memory");              \
                     for (int d_ = 0; d_ < 4; ++d_) for (int r = 0; r < 16; ++r) o[d_][r] *= al_l[crow(r, hi)]; } } while (0)
#define KBASE(t) ((t) * KVBLK)
#define MASKT(P0_, P1_, t) do { const int kb_ = KBASE(t);                                                                                   \
        if constexpr (KIND == 0) { if (kb_ >= cur.P0) { if (kb_ + KVBLK - 1 > qlo) mask_causal(P0_, P1_, qm - kb_); }                      \
            else { const bool al_ = (selw >> (kb_ >> 8)) & 1u; if (!__all(al_)) { if (!al_) { const float NEG_ = -__builtin_inff();        \
                _Pragma("unroll") for (int r_ = 0; r_ < 16; ++r_) { P0_[r_] = NEG_; P1_[r_] = NEG_; } } } } }                             \
        else { mask_bits(P0_, P1_, (unsigned)mcur >> (4 * hi), (unsigned)(mcur >> 32) >> (4 * hi)); } } while (0)
    f32x16 pA0, pA1, pB0, pB1; float mnA, mnB, alA, alB; f16x8 pa0, pa1, pa2, pa3;
    {
#pragma unroll
        for (int d0 = 0; d0 < 8; ++d0) { const f16x8 qv = load8(cur.Q + (size_t)(wid * QBLK + r32) * D + d0 * 16 + hi * 8);
            if (QREG) qr[d0] = qv; else *(f16x8*)(Qw_lds + KSWZ(r32, (d0 * 16 + hi * 8) * 2)) = qv; }
        SLOAD_H(Kh, Vh, 0); VMW(); SWRITE_H(0);
    }
    __syncthreads();
    if (NT > 1) { SLOAD_H(Kh, Vh, KBASE(1)); }
    MLOAD(0); SBAR(); qkt<0, QREG>(pA0, pA1, K_lds, Qw_lds, r32, hi, qr); asm volatile("s_nop 15\n\ts_nop 7" : "+v"(pA0), "+v"(pA1));
    MASKT(pA0, pA1, 0); partialSM(pA0, pA1, m_reg, mnA, alA);
    if (NT > 1) { VMW(); SWRITE_H(1); }
    __syncthreads();
#define HALF_STEP(PX0, PX1, mnX, alX, PY0, PY1, alY, t, KB, VB, SB) do {                                                      \
        MLOAD(t); SBAR(); qkt<KB, QREG>(PX0, PX1, K_lds, Qw_lds, r32, hi, qr);                                                          \
        finishSM(PY0, PY1, alY, l_reg, pa0, pa1, pa2, pa3); SBAR();                                                           \
        if ((t) + 1 < NT) { SLOAD_H(Kh, Vh, KBASE((t) + 1)); SBAR(); }                                                        \
          \
        ATT_PVG(VB, 0); MASKT(PX0, PX1, (t)); const float pmx_ = sm_max(PX0, PX1); SBAR();                                    \
        ATT_PVG(VB, 1); const float mnl_ = sm_decide(pmx_, m_reg, mnX, alX); sm_fma(PX0, mnl_); SBAR();                       \
        ATT_PVG(VB, 2); sm_fma(PX1, mnl_); SBAR();                                                                            \
        ATT_PVG(VB, 3); sm_exp(PX0);                                                                                          \
        __syncthreads();                                                                                                      \
        if ((t) + 1 < NT) { VMW(); SWRITE_H(SB); }                                                                            \
        RESC(alX); __syncthreads(); } while (0)
    for (int t = 1; t + 1 < NT; t += 2) {
        HALF_STEP(pB0, pB1, mnB, alB, pA0, pA1, alA, t, 1, 0, 0);
        HALF_STEP(pA0, pA1, mnA, alA, pB0, pB1, alB, t + 1, 0, 1, 1);
    }
    MLOAD(NT - 1); SBAR(); qkt<1, QREG>(pB0, pB1, K_lds, Qw_lds, r32, hi, qr); SBAR();
    finishSM(pA0, pA1, alA, l_reg, pa0, pa1, pa2, pa3); SBAR();
    pv_tile<0>(o, vb0, pa0, pa1, pa2, pa3);
    MASKT(pB0, pB1, NT - 1); partialSM(pB0, pB1, m_reg, mnB, alB); RESC(alB);
    finishSM(pB0, pB1, alB, l_reg, pa0, pa1, pa2, pa3); SBAR(); pv_tile<1>(o, vb0, pa0, pa1, pa2, pa3);
    if (hi == 0) li_l[r32] = l_reg; asm volatile("s_waitcnt lgkmcnt(0)" ::: "memory");
    float rli[16];
#pragma unroll
    for (int r = 0; r < 16; ++r) rli[r] = __builtin_amdgcn_rcpf(li_l[crow(r, hi)]);
    int le = lane; asm volatile("" : "+v"(le));
    f16* Ow = cur.O + (size_t)(wid * QBLK) * AW; f16* stg = (f16*)(lds + LDS_Q) + wid * 4096; f16* sw = stg + (4 * (le >> 5)) * 128 + (le & 31);
#pragma unroll
    for (int r = 0; r < 16; ++r) { const int ob = ((r & 3) + 8 * (r >> 2)) * 128;
#pragma unroll
        for (int d0 = 0; d0 < 4; ++d0) sw[ob + d0 * 32] = (f16)(o[d0][r] * rli[r]); }
    asm volatile("s_waitcnt lgkmcnt(0)" ::: "memory");
    const f16* sr_ = stg + (le >> 4) * 128 + (le & 15) * 8; f16* og = Ow + (size_t)(le >> 4) * AW + (le & 15) * 8;
#pragma unroll
    for (int i = 0; i < 8; ++i) { const u32x4 v = *(const u32x4*)(sr_ + i * 4 * 128); *(u32x4*)(og + (size_t)i * 4 * AW) = v; }
    __syncthreads();
#undef RESC
#undef KBASE
#undef MASKT
#undef MLOAD
#undef HALF_STEP
}
#undef ROW
#undef VMW
#undef SLOAD_H
#undef SWRITE_HK
#undef SWRITE_HV
#undef SWRITE_H
#undef SBAR
}

constexpr int NWAVES = 8;
constexpr int RING_BYTES = 131072;
constexpr int LDSCTL_OFF = 146432, MISC_OFF = LDSCTL_OFF + 320;
constexpr int LDS_BYTES = 147456;
constexpr int CW_TMO = 0, CW_QUEUE = 64, CW_QUEUE2 = 128, CW_BAR = 4096;
typedef GAS unsigned gu32;
#define RLX_AGENT __ATOMIC_RELAXED, __HIP_MEMORY_SCOPE_AGENT

#define XB_TMO      128
#define XB_XCNT(j)  (256  + 64 * (j))
#define XB_XSUB(j)  (1280 + 64 * (j))
#define XB_XGEN(j)  (2304 + 64 * (j))
#define XB_TOP      3328
#define XB_TOPGEN   3392
#define XCD_BAR_WORDS 3456
#define XB_SPIN_CAP (1u << 20)
__device__ __forceinline__ unsigned xb_ld(unsigned* p)              { return __hip_atomic_load(p, __ATOMIC_RELAXED, __HIP_MEMORY_SCOPE_AGENT); }
__device__ __forceinline__ unsigned xb_add(unsigned* p, unsigned v) { return __hip_atomic_fetch_add(p, v, __ATOMIC_RELAXED, __HIP_MEMORY_SCOPE_AGENT); }
__device__ __forceinline__ unsigned xb_xcc_id() { return (unsigned)__builtin_amdgcn_s_getreg((3 << 11) | 20) & 0xFu; }
#define XB_SPIN(cond, bar) do { unsigned _sp = 0; while (cond) { __builtin_amdgcn_s_sleep(1); \
    if ((++_sp & 255u) == 0u) { if (xb_ld(&(bar)[XB_TMO])) break; if (_sp > XB_SPIN_CAP) { atomicAdd(&(bar)[XB_TMO], 1u); break; } } } } while (0)
struct XcdBarrier { unsigned* bar; unsigned x; volatile LAS unsigned* st; };
__device__ __forceinline__ XcdBarrier xcd_barrier_post(unsigned* bar, volatile LAS unsigned* st) {
    XcdBarrier b; b.bar = bar; b.x = xb_xcc_id(); b.st = st;
    if (threadIdx.x == 0) (void)xb_add(&bar[XB_XCNT(b.x)], 1u);
    return b;
}
__device__ __forceinline__ void xcd_barrier_complete(unsigned* bar, unsigned x, unsigned& nloc, unsigned& nx) {
    const unsigned G = gridDim.x * gridDim.y * gridDim.z;
    unsigned sum, cnt, mine, sp = 0u;
    for (;;) {
        sum = 0u; cnt = 0u; mine = 0u;
#pragma unroll
        for (unsigned j = 0; j < 16; ++j) { const unsigned c = xb_ld(&bar[XB_XCNT(j)]); sum += c; cnt += (c > 0u) ? 1u : 0u; mine = (j == x) ? c : mine; }
        if (sum == G) break;
        __builtin_amdgcn_s_sleep(1);
        if ((++sp & 255u) == 0u) { if (xb_ld(&bar[XB_TMO])) break; if (sp > XB_SPIN_CAP) { atomicAdd(&bar[XB_TMO], 1u); break; } }
    }
    nloc = mine > 0u ? mine : 1u; nx = cnt > 0u ? cnt : 1u;
}
__device__ __forceinline__ void xcd_barrier(const XcdBarrier& b) {
    asm volatile("s_waitcnt vmcnt(0)" ::: "memory");
    __syncthreads();
    if (threadIdx.x == 0) {
        unsigned* bar = b.bar;
        __builtin_amdgcn_s_waitcnt(0);
        unsigned nloc = b.st[0], nx = b.st[1];
        if (nloc == 0u) { xcd_barrier_complete(bar, b.x, nloc, nx); b.st[0] = nloc; b.st[1] = nx; }
        const unsigned old = xb_add(&bar[XB_XSUB(b.x)], 1u);
        const unsigned gen = old / nloc;
        if (old + 1u == (gen + 1u) * nloc) {
            __builtin_amdgcn_fence(__ATOMIC_RELEASE, "agent");
            asm volatile("s_waitcnt vmcnt(0)" ::: "memory");
            const unsigned og = xb_add(&bar[XB_TOP], 1u);
            const unsigned tg = og / nx;
            if (og + 1u == (tg + 1u) * nx) xb_add(&bar[XB_TOPGEN], 1u);
            else XB_SPIN(xb_ld(&bar[XB_TOPGEN]) == tg, bar);
            __builtin_amdgcn_fence(__ATOMIC_ACQUIRE, "agent");
            xb_add(&bar[XB_XGEN(b.x)], 1u);
            asm volatile("s_waitcnt vmcnt(0)" ::: "memory");
        } else {
            XB_SPIN(xb_ld(&bar[XB_XGEN(b.x)]) == gen, bar);
            __builtin_amdgcn_fence(__ATOMIC_ACQUIRE, "agent");
            asm volatile("s_waitcnt vmcnt(0)" ::: "memory");
        }
    }
    __syncthreads();
}

struct Args { const float* in[14]; float* out; unsigned char* ws; int ph_lo, ph_hi; };
constexpr int PTRTAB_OFF = LDSCTL_OFF + 512;
__device__ __forceinline__ const float* ldptr(LAS unsigned char* lds, int i) {
    const LAS unsigned* p = (const LAS unsigned*)(lds + PTRTAB_OFF) + 2 * i; asm volatile("" ::: "memory");
    const unsigned lo = __builtin_amdgcn_readfirstlane(p[0]), hi = __builtin_amdgcn_readfirstlane(p[1]);
    return (const float*)(((u64)hi << 32) | lo);
}

__device__ __forceinline__ void conv_load(f32x4 (&r)[16], const float* src0, const float* src1, int N, int lane) {
    const float* sp = (lane & 8) ? src1 : src0;
    if (sp) {
#pragma unroll
        for (int i = 0; i < 16; ++i) r[i] = __builtin_nontemporal_load((const f32x4*)(sp + (size_t)(4 * i + (lane >> 4)) * N + 4 * (lane & 7)));
    } else {
#pragma unroll
        for (int i = 0; i < 16; ++i) r[i] = (f32x4){0.f, 0.f, 0.f, 0.f};
    }
}
__device__ __forceinline__ void conv_store(const f32x4 (&r)[16], f16* dst, int K, LAS float* scr, int lane) {
#pragma unroll
    for (int i = 0; i < 16; ++i) { LAS float* wp = scr + (4 * i + (lane >> 4)) * 65 + 4 * (lane & 15); wp[0] = r[i][0]; wp[1] = r[i][1]; wp[2] = r[i][2]; wp[3] = r[i][3]; }
    LDS_WAIT(); asm volatile("" ::: "memory");
    const int c = lane & 7;
#pragma unroll
    for (int j = 0; j < 8; ++j) { const int n = (lane >> 3) + 8 * j; const LAS float* sp = scr + (8 * c) * 65 + n;
        if (K < 0) { int w0 = 0, w1 = 0;
            w0 = __builtin_amdgcn_cvt_pk_fp8_f32(sp[0 * 65] * 256.f, sp[1 * 65] * 256.f, w0, false); w0 = __builtin_amdgcn_cvt_pk_fp8_f32(sp[2 * 65] * 256.f, sp[3 * 65] * 256.f, w0, true);
            w1 = __builtin_amdgcn_cvt_pk_fp8_f32(sp[4 * 65] * 256.f, sp[5 * 65] * 256.f, w1, false); w1 = __builtin_amdgcn_cvt_pk_fp8_f32(sp[6 * 65] * 256.f, sp[7 * 65] * 256.f, w1, true);
            *(GAS u32x2*)((unsigned char*)dst + (size_t)n * (size_t)(-K) + 8 * c) = (u32x2){(unsigned)w0, (unsigned)w1}; continue; }
        u32x4 o; o.x = pkh(sp[0 * 65], sp[1 * 65]); o.y = pkh(sp[2 * 65], sp[3 * 65]); o.z = pkh(sp[4 * 65], sp[5 * 65]); o.w = pkh(sp[6 * 65], sp[7 * 65]);
        *(GAS u32x4*)(dst + (size_t)n * K + 8 * c) = o; }
    LDS_WAIT(); asm volatile("" ::: "memory");
}
template <class Dec>
__device__ __forceinline__ void conv_stream(int first, int total, int stride, const Dec& dec, LAS float* scr, int lane) {
    int it = first; if (it >= total) return;
    f32x4 ra[16], rb[16];
    const float* a0; const float* a1; f16* ad; int aK, aN; const float* b0; const float* b1; f16* bd; int bK, bN;
    dec(it, a0, a1, ad, aK, aN); b0 = a0; b1 = a1; bd = ad; bK = aK; bN = aN; conv_load(ra, a0, a1, aN, lane);
    for (;;) {
        bool more = it + stride < total; if (more) { dec(it + stride, b0, b1, bd, bK, bN); conv_load(rb, b0, b1, bN, lane); }
        conv_store(ra, ad, aK, scr, lane); if (!more) break; it += stride;
        more = it + stride < total; if (more) { dec(it + stride, a0, a1, ad, aK, aN); conv_load(ra, a0, a1, aN, lane); }
        conv_store(rb, bd, bK, scr, lane); if (!more) break; it += stride;
    }
}
__device__ __forceinline__ int win_src_col(int rb) {
    const int pn = rb >> 3, jb = rb & 7, bj = jb >> 2, qq = jb & 3;
    if (pn < 24) { const int kind6 = pn >> 2, hp = pn & 3, base = kind6 * AW;
        if ((kind6 % 3) != 2) return base + (2 * hp + (qq >> 1)) * HD + 32 * (qq & 1) + 64 * bj;
        return base + hp * 256 + 32 * jb; }
    if (pn < 28) return C_QI + (4 * (pn - 24) + qq) * IDXD + 32 * bj;
    if (pn == 28) { if (jb == 0) return C_KI; if (jb == 4) return C_KI + 32; if (jb == 1) return C_WI; return -1; }
    if (pn < 37) return C_GA + (pn - 29) * 256 + 32 * jb;
    return C_GB + (pn - 37) * 256 + 32 * jb;
}
constexpr int CONV_I_IN = (DM / 64) * (N_IN_PAD / 64), CONV_I_MO = (AW / 64) * (DM / 64), CONV_I_O = (DM / 64) * (DM / 64), CONV_I_1 = (DM / 64) * (FF / 64), CONV_I_2 = (FF / 64) * (DM / 64);
constexpr int CONV_TOTAL = CONV_I_IN + 2 * CONV_I_MO + CONV_I_O + CONV_I_1 + CONV_I_2;
constexpr int CONV_SPLIT = CONV_I_IN + 2 * CONV_I_MO + CONV_I_O;
__device__ __forceinline__ void conv_items(unsigned char* ws, const float* win, const float* wmo, const float* wdo, const float* wo, const float* w1, const float* w2,
                                           LAS unsigned char* lds, int lo, int hi, int first, int stride, int wave, int lane) {
    constexpr int I_IN = CONV_I_IN, I_MO = CONV_I_MO, I_O = CONV_I_O, I_1 = CONV_I_1;
    LAS float* scr64 = (LAS float*)(lds + wave * 16640);
    conv_stream(lo + first, hi, stride, [&](int r, const float*& s0, const float*& s1, f16*& dst, int& K, int& N) {
            if (r < I_IN) { const int nb = N_IN_PAD / 64, kb = r / nb, rbd = r % nb; const float* base = win + (size_t)kb * 64 * D_IN; N = D_IN;
                const bool f8 = rbd >= 84; const int q = f8 ? rbd - 84 : rbd, p_ = q >> 2, pt = f8 ? (p_ < 4 ? 8 + p_ : (p_ < 8 ? 16 + p_ : 21 + p_)) : (p_ < 8 ? p_ : (p_ < 16 ? p_ + 4 : p_ + 8));
                const int rb = pt * 4 + (q & 3), c0 = win_src_col(2 * rb), c1 = win_src_col(2 * rb + 1);
                s0 = c0 >= 0 ? base + c0 : nullptr; s1 = c1 >= 0 ? base + c1 : nullptr;
                if (f8) { dst = (f16*)((unsigned char*)(ws + WS_WG8) + (size_t)q * 64 * DM + kb * 64); K = -DM; } else { dst = (f16*)(ws + WS_WIN) + (size_t)q * 64 * DM + kb * 64; K = DM; }
                return; }
            r -= I_IN; const float* W; f16* WT;
            if (r < I_MO) { W = wmo; WT = (f16*)(ws + WS_WMO); K = AW; N = DM; }
            else if ((r -= I_MO) < I_MO) { W = wdo; WT = (f16*)(ws + WS_WDO); K = AW; N = DM; }
            else if ((r -= I_MO) < I_O) { const int nb = DM / 64, kb = r / nb, rb = r % nb;
                s0 = wo + (size_t)kb * 64 * DM + rb * 64; s1 = s0 + 32; dst = (f16*)((unsigned char*)(ws + WS_WO) + (size_t)rb * 64 * DM + kb * 64); K = -DM; N = DM; return; }
            else if ((r -= I_O) < I_1) { W = w1; WT = (f16*)(ws + WS_W1); K = DM; N = FF; }
            else { r -= I_1; const int nb = DM / 64, kb = r / nb, rb = r % nb;
                s0 = w2 + (size_t)kb * 64 * DM + rb * 64; s1 = s0 + 32; dst = (f16*)((unsigned char*)(ws + WS_W2) + (size_t)rb * 64 * FF + kb * 64); K = -FF; N = DM; return; }
            const int nb = N / 64, kb = r / nb, rb = r % nb;
            s0 = W + (size_t)kb * 64 * N + rb * 64; s1 = s0 + 32; dst = WT + (size_t)rb * 64 * K + kb * 64; }, scr64, lane);
}
__device__ __forceinline__ void p0_prologue(const Args& a, LAS unsigned char* lds, int vcu, int G, int wave, int lane, int tid) {
    unsigned char* ws = a.ws;
    LAS float* scr = (LAS float*)(lds + wave * 16384);
    const int gw = vcu * NWAVES + wave, NGW = G * NWAVES;
    {
        const float* c = a.in[1]; const float* wada = a.in[2]; float* modp = (float*)(ws + WS_MODP);
        for (int it = gw; it < 64 * 32; it += NGW) {
            const int cc = it & 63, kc = it >> 6, k0 = kc * 64;
            if (lane < 48) {
                f32x4 a0 = {0.f, 0.f, 0.f, 0.f}, a1 = {0.f, 0.f, 0.f, 0.f};
                const float* wp = wada + (size_t)k0 * (6 * DM) + cc * 192 + lane * 4;
#pragma unroll 16
                for (int kk = 0; kk < 64; ++kk) {
                    const f32x4 wv = __builtin_nontemporal_load((const f32x4*)(wp + (size_t)kk * (6 * DM)));
                    const float c0 = c[k0 + kk], c1 = c[DM + k0 + kk];
                    const float s0 = c0 * sigmoidf_(c0), s1 = c1 * sigmoidf_(c1);
                    a0 += wv * s0; a1 += wv * s1;
                }
                *(f32x4*)(modp + (size_t)(kc * 2 + 0) * (6 * DM) + cc * 192 + lane * 4) = a0;
                *(f32x4*)(modp + (size_t)(kc * 2 + 1) * (6 * DM) + cc * 192 + lane * 4) = a1;
            }
        }
    }
    conv_items(ws, a.in[6], a.in[7], a.in[8], a.in[9], a.in[12], a.in[13], lds, 0, CONV_SPLIT, gw, NGW, wave, lane);
    {
        float* ra = (float*)(ws + WS_ROPEA); float* rb = (float*)(ws + WS_ROPEB);
        const int gt = vcu * (NWAVES * 64) + tid, NGT = G * NWAVES * 64;
        for (int i = gt; i < SEQ * 64 + SEQ * 32; i += NGT) {
            int t, f, half; float* dst;
            if (i < SEQ * 64) { t = i >> 6; f = i & 63; half = 64; dst = ra + (size_t)(i >> 2) * 8 + (i & 3); } else { const int j = i - SEQ * 64; t = j >> 5; f = j & 31; half = 32; dst = rb + (size_t)(j >> 2) * 8 + (j & 3); }
            const float inv = (float)exp2(-(double)f / (double)half * 13.287712379549449);
            const float ang = (float)t * inv;
            double sn, cs; sn = sin((double)ang); cs = cos((double)ang);
            dst[0] = (float)cs; dst[4] = (float)sn;
        }
    }
}

__device__ __forceinline__ f32x4 mod4(const float* modp, const float* bada, int b, int j) {
    f32x4 s = *(const f32x4*)(bada + j);
#pragma unroll
    for (int kc = 0; kc < 32; ++kc) s += *(const f32x4*)(modp + (size_t)(kc * 2 + b) * (6 * DM) + j);
    return s;
}
__device__ __forceinline__ void p1_norm_in(const Args& a, LAS unsigned char* lds, int vcu, int G, int wave, int lane, int tid) {
    unsigned char* ws = a.ws; const float* x = a.in[0]; const float* modp = (const float*)(ws + WS_MODP); const float* bada = a.in[3]; const float* g = a.in[4];
    f16* h = (f16*)(ws + WS_H);
    LAS float* A1 = (LAS float*)lds; LAS float* B1 = A1 + DM;
    int curb = -1;
    { float* modf = (float*)(ws + WS_MODF); const int per = (2 * 6 * DM + G - 1) / G;
      for (int e = tid; e < per; e += NWAVES * 64) { const int idx = vcu * per + e; if (idx < 2 * 6 * DM) { const int b = idx / (6 * DM), j = idx % (6 * DM); float sacc = bada[j];
          for (int kc = 0; kc < 32; ++kc) sacc += modp[(size_t)(kc * 2 + b) * (6 * DM) + j]; modf[idx] = sacc; } } }
    for (int rg = vcu; rg < MTOK / 32; rg += G) {
        const int b = rg >> 7;
        if (b != curb) { __syncthreads(); curb = b; const int j = tid * 4;
            const f32x4 sh = mod4(modp, bada, b, 0 * DM + j), sc = mod4(modp, bada, b, 1 * DM + j), gg = *(const f32x4*)(g + j);
            *(LAS f32x4*)(A1 + j) = gg * (1.0f + sc); *(LAS f32x4*)(B1 + j) = sh; __syncthreads(); }
        f32x4 v[8], vn[8];
        { const f32x4* xr = (const f32x4*)(x + (size_t)(rg * 32 + wave * 4) * DM) + lane;
#pragma unroll
          for (int j = 0; j < 8; ++j) v[j] = __builtin_nontemporal_load(xr + 64 * j); }
#pragma unroll
        for (int rr = 0; rr < 4; ++rr) { const int row = rg * 32 + wave * 4 + rr;
            if (rr < 3) { const f32x4* xr = (const f32x4*)(x + (size_t)(row + 1) * DM) + lane;
#pragma unroll
                for (int j = 0; j < 8; ++j) vn[j] = __builtin_nontemporal_load(xr + 64 * j); }
            float ss = 0.f;
#pragma unroll
            for (int j = 0; j < 8; ++j) ss += (v[j][0] * v[j][0] + v[j][1] * v[j][1]) + (v[j][2] * v[j][2] + v[j][3] * v[j][3]);
            const float rstd = 1.0f / sqrtf(wave_sum(ss) * (1.0f / DM) + RMS_EPS);
            u32x2* o8 = (u32x2*)(h + (size_t)row * DM) + lane; unsigned* o4 = (unsigned*)((unsigned char*)(ws + WS_H8) + (size_t)row * DM) + lane;
#pragma unroll
            for (int j = 0; j < 8; ++j) { const int c = 4 * lane + 256 * j; const f32x4 aa = *(LAS f32x4*)(A1 + c), bb = *(LAS f32x4*)(B1 + c); const f32x4 r = v[j] * rstd * aa + bb;
                u32x2 w; w.x = pkh(r[0], r[1]); w.y = pkh(r[2], r[3]); o8[64 * j] = w;
                int w8 = 0; w8 = __builtin_amdgcn_cvt_pk_fp8_f32(r[0], r[1], w8, false); w8 = __builtin_amdgcn_cvt_pk_fp8_f32(r[2], r[3], w8, true); o4[64 * j] = (unsigned)w8; }
#pragma unroll
            for (int j = 0; j < 8; ++j) v[j] = vn[j]; }
    }
}
__device__ __forceinline__ void p7_mid(const Args& a, LAS unsigned char* lds, int vcu, int G, int wave, int lane, int tid) {
    unsigned char* ws = (unsigned char*)ldptr(lds, 6); const float* x = ldptr(lds, 0); const float* modp = (const float*)(ws + WS_MODP); const float* bada = ldptr(lds, 1);
    const float* gpost = ldptr(lds, 2); const float* gpre = ldptr(lds, 3);
    const f16* z = (const f16*)(ws + WS_QKV + 32 * MiB); const float* ssp = (const float*)(ws + WS_SSP1); f16* h2 = (f16*)(ws + WS_H); f16* x1o = (f16*)(ws + WS_WIN);
    LAS float* G1 = (LAS float*)lds; LAS float* A2 = G1 + DM; LAS float* B2 = A2 + DM;
    int curb = -1;
    for (int rg = vcu; rg < MTOK / 32; rg += G) {
        const int b = rg >> 7;
        if (b != curb) { __syncthreads(); curb = b; const int j = tid * 4;
            const float* modf = (const float*)(ws + WS_MODF) + (size_t)b * (6 * DM);
            const f32x4 gt1 = *(const f32x4*)(modf + 2 * DM + j), sh2 = *(const f32x4*)(modf + 3 * DM + j), sc2 = *(const f32x4*)(modf + 4 * DM + j);
            *(LAS f32x4*)(G1 + j) = gt1 * *(const f32x4*)(gpost + j); *(LAS f32x4*)(A2 + j) = *(const f32x4*)(gpre + j) * (1.0f + sc2); *(LAS f32x4*)(B2 + j) = sh2; __syncthreads(); }
        f32x4 xv[8], xn[8]; u32x2 zv[8], zn[8]; float spv, spn = 0.f;
        { const int row = rg * 32 + wave * 4; const f32x4* xr = (const f32x4*)(x + (size_t)row * DM) + lane; const u32x2* zr = (const u32x2*)(z + (size_t)row * DM) + lane;
          spv = lane < 32 ? ssp[(size_t)row * 32 + lane] : 0.f;
#pragma unroll
          for (int j = 0; j < 8; ++j) { xv[j] = __builtin_nontemporal_load(xr + 64 * j); zv[j] = __builtin_nontemporal_load(zr + 64 * j); } }
#pragma unroll
        for (int rr = 0; rr < 4; ++rr) { const int row = rg * 32 + wave * 4 + rr;
            if (rr < 3) { const f32x4* xr = (const f32x4*)(x + (size_t)(row + 1) * DM) + lane; const u32x2* zr = (const u32x2*)(z + (size_t)(row + 1) * DM) + lane;
                spn = lane < 32 ? ssp[(size_t)(row + 1) * 32 + lane] : 0.f;
#pragma unroll
                for (int j = 0; j < 8; ++j) { xn[j] = __builtin_nontemporal_load(xr + 64 * j); zn[j] = __builtin_nontemporal_load(zr + 64 * j); } }
            const float rstd1 = 1.0f / sqrtf(wave_sum(spv) * (1.0f / DM) + RMS_EPS);
            u32x2* xo = (u32x2*)(x1o + (size_t)row * DM) + lane;
            f32x4 v[8]; float ss = 0.f;
#pragma unroll
            for (int j = 0; j < 8; ++j) { const int c = 4 * lane + 256 * j; const f32x2 z0 = unpkh(zv[j].x), z1 = unpkh(zv[j].y); const f32x4 zz = {z0.x, z0.y, z1.x, z1.y};
                v[j] = xv[j] + *(LAS f32x4*)(G1 + c) * zz * rstd1; { u32x2 xw; xw.x = pkh(v[j][0], v[j][1]); xw.y = pkh(v[j][2], v[j][3]); xo[64 * j] = xw; }
                ss += (v[j][0] * v[j][0] + v[j][1] * v[j][1]) + (v[j][2] * v[j][2] + v[j][3] * v[j][3]); }
            const float rstd2 = 1.0f / sqrtf(wave_sum(ss) * (1.0f / DM) + RMS_EPS);
            u32x2* o8 = (u32x2*)(h2 + (size_t)row * DM) + lane;
#pragma unroll
            for (int j = 0; j < 8; ++j) { const int c = 4 * lane + 256 * j; const f32x4 r = v[j] * rstd2 * *(LAS f32x4*)(A2 + c) + *(LAS f32x4*)(B2 + c);
                u32x2 w; w.x = pkh(r[0], r[1]); w.y = pkh(r[2], r[3]); o8[64 * j] = w; }
#pragma unroll
            for (int j = 0; j < 8; ++j) { xv[j] = xn[j]; zv[j] = zn[j]; }
            spv = spn; }
    }
}
__device__ __forceinline__ void p10_final(const Args& a, LAS unsigned char* lds, int vcu, int G, int wave, int lane, int tid) {
    unsigned char* ws = (unsigned char*)ldptr(lds, 6); const float* modp = (const float*)(ws + WS_MODP); const float* bada = ldptr(lds, 1); const float* gpost = ldptr(lds, 4);
    const f16* f = (const f16*)(ws + WS_F); const float* ssp = (const float*)(ws + WS_SSP2); float* out = (float*)ldptr(lds, 5); const f16* x1h = (const f16*)(ws + WS_WIN);
    LAS float* G2 = (LAS float*)lds;
    int curb = -1;
    for (int rg = vcu; rg < MTOK / 32; rg += G) {
        const int b = rg >> 7;
        if (b != curb) { __syncthreads(); curb = b; const int j = tid * 4;
            const f32x4 gt2 = *(const f32x4*)((const float*)(ws + WS_MODF) + (size_t)b * (6 * DM) + 5 * DM + j); *(LAS f32x4*)(G2 + j) = gt2 * *(const f32x4*)(gpost + j); __syncthreads(); }
        u32x2 fv[8], fn[8], xv[8], xn[8]; float spv, spn = 0.f;
        { const int row = rg * 32 + wave * 4; const u32x2* fr = (const u32x2*)(f + (size_t)row * DM) + lane; const u32x2* xr = (const u32x2*)(x1h + (size_t)row * DM) + lane;
          spv = lane < 32 ? ssp[(size_t)row * 32 + lane] : 0.f;
#pragma unroll
          for (int j = 0; j < 8; ++j) { fv[j] = __builtin_nontemporal_load(fr + 64 * j); xv[j] = __builtin_nontemporal_load(xr + 64 * j); } }
#pragma unroll
        for (int rr = 0; rr < 4; ++rr) { const int row = rg * 32 + wave * 4 + rr;
            if (rr < 3) { const u32x2* fr = (const u32x2*)(f + (size_t)(row + 1) * DM) + lane; const u32x2* xr = (const u32x2*)(x1h + (size_t)(row + 1) * DM) + lane;
                spn = lane < 32 ? ssp[(size_t)(row + 1) * 32 + lane] : 0.f;
#pragma unroll
                for (int j = 0; j < 8; ++j) { fn[j] = __builtin_nontemporal_load(fr + 64 * j); xn[j] = __builtin_nontemporal_load(xr + 64 * j); } }
            const float rstd = 1.0f / sqrtf(wave_sum(spv) * (1.0f / DM) + RMS_EPS);
            f32x4* xo = (f32x4*)(out + (size_t)row * DM) + lane;
#pragma unroll
            for (int j = 0; j < 8; ++j) { const int c = 4 * lane + 256 * j; const f32x2 f0 = unpkh(fv[j].x), f1 = unpkh(fv[j].y); const f32x4 ff = {f0.x, f0.y, f1.x, f1.y};
                const f32x2 x0 = unpkh(xv[j].x), x1v = unpkh(xv[j].y); const f32x4 xx = {x0.x, x0.y, x1v.x, x1v.y};
                __builtin_nontemporal_store(xx + *(LAS f32x4*)(G2 + c) * ff * rstd, xo + 64 * j); }
#pragma unroll
            for (int j = 0; j < 8; ++j) { fv[j] = fn[j]; xv[j] = xn[j]; }
            spv = spn; }
    }
}

__device__ __forceinline__ unsigned fkey(float f) { const unsigned u = __float_as_uint(f); return (u & 0x80000000u) ? ~u : (u | 0x80000000u); }
#define SEL_BODY(NC_)         { \
            const int t = t0 + wave; LAS unsigned* row = sc + wave * SEQ; \
            float v[NC_]; \
_Pragma("unroll") \
            for (int i = 0; i < NC_; ++i) v[i] = __uint_as_float(row[i * 64 + lane]); \
            float thr = -__builtin_inff(); \
            if (t + 1 > DSA_TOPK) { \
                float mx = -__builtin_inff(), mn = __builtin_inff(); \
_Pragma("unroll") \
                for (int i = 0; i < NC_; ++i) { asm("v_max_f32 %0, %0, %1" : "+v"(mx) : "v"(v[i])); asm("v_min_f32 %0, %0, %1" : "+v"(mn) : "v"(v[i])); } \
_Pragma("unroll") \
                for (int o = 1; o < 64; o <<= 1) { mx = __builtin_fmaxf(mx, __shfl_xor(mx, o)); mn = __builtin_fminf(mn, __shfl_xor(mn, o)); } \
                const float scale = (mx > mn) ? 4094.5f / (mx - mn) : 0.f, off = -mn * scale; \
                LDS_WAIT(); \
_Pragma("unroll") \
                for (int i = 0; i < 16; ++i) *(LAS u32x4*)(row + (i * 64 + lane) * 4) = (u32x4){0u, 0u, 0u, 0u}; \
                LDS_WAIT(); \
_Pragma("unroll") \
                for (int i = 0; i < NC_; ++i) { \
                    const unsigned bb = (v[i] == v[i]) ? (unsigned)(int)__builtin_fmaf(v[i], scale, off) : (unsigned)lane; \
                    __hip_atomic_fetch_add(row + bb, 1u, __ATOMIC_RELAXED, __HIP_MEMORY_SCOPE_WORKGROUP); \
                    if ((i & 7) == 7) __builtin_amdgcn_sched_barrier(0); } \
                __hip_atomic_fetch_sub(row + lane, (unsigned)(NC_ - 1 - ((t - lane) >> 6)), __ATOMIC_RELAXED, __HIP_MEMORY_SCOPE_WORKGROUP); \
                LDS_WAIT(); \
                unsigned qs[16], S = 0; \
_Pragma("unroll") \
                for (int i = 0; i < 16; ++i) { const u32x4 h4 = *(const LAS u32x4*)(row + lane * 64 + i * 4); qs[i] = (h4.x + h4.y) + (h4.z + h4.w); S += qs[i]; if ((i & 3) == 3) __builtin_amdgcn_sched_barrier(0); } \
                unsigned suf = S; \
_Pragma("unroll") \
                for (int o = 1; o < 64; o <<= 1) { const unsigned y = __shfl_down(suf, o); suf += (lane + o < 64) ? y : 0u; } \
                const unsigned above = suf - S; \
                unsigned run = above; int qB = 0; unsigned runq = above; bool found = false; \
_Pragma("unroll") \
                for (int qd = 15; qd >= 0; --qd) { const bool hit = !found && (run + qs[qd] >= (unsigned)DSA_TOPK); if (hit) { qB = qd; runq = run; found = true; } run += qs[qd]; } \
                unsigned jB = 0, cabv = 0; \
                { const u32x4 h4 = *(const LAS u32x4*)(row + lane * 64 + qB * 4); unsigned r2 = runq; bool f2 = false; \
_Pragma("unroll") \
                  for (int e = 3; e >= 0; --e) { const bool hit = !f2 && (r2 + h4[e] >= (unsigned)DSA_TOPK); if (hit) { jB = (unsigned)(qB * 4 + e); cabv = r2; f2 = true; } r2 += h4[e]; } } \
                const u64 crossing = __ballot(above < (unsigned)DSA_TOPK && suf >= (unsigned)DSA_TOPK); \
                const int L = (int)__builtin_ctzll(crossing); \
                const unsigned B = (unsigned)__builtin_amdgcn_readlane((int)(jB + 64u * lane), L), cab = (unsigned)__builtin_amdgcn_readlane((int)cabv, L); \
                const int need = DSA_TOPK - (int)cab; \
                LDS_WAIT(); \
                const float blo = B ? (float)B : -__builtin_inff(), bhi = (float)(B + 1); \
                int occ = 0; \
_Pragma("unroll") \
                for (int i = 0; i < NC_; ++i) { float vi = v[i]; asm volatile("" : "+v"(vi)); \
                    const float x = __builtin_fmaf(vi, scale, off); const bool c = (x >= blo) && (x < bhi); \
                    const u64 m = __ballot(c); \
                    if (m) { const int pos = occ + (int)__builtin_popcountll(m & ((1ull << lane) - 1ull)); if (c && pos < 64) row[pos] = __float_as_uint(vi); occ += (int)__builtin_popcountll(m); } \
                    __builtin_amdgcn_sched_barrier(0); } \
                LDS_WAIT(); \
                if (occ <= 64) { \
                    const float cl = (lane < occ) ? __uint_as_float(row[lane]) : -__builtin_inff(); int gt = 0, ge = 0; \
                    for (int j = 0; j < occ; ++j) { const float x = __uint_as_float(row[j]); gt += (x > cl) ? 1 : 0; ge += (x >= cl) ? 1 : 0; } \
                    const u64 hitm = __ballot(lane < occ && gt < need && need <= ge); \
                    thr = __uint_as_float((unsigned)__builtin_amdgcn_readlane((int)__float_as_uint(cl), (int)__builtin_ctzll(hitm))); \
                } else { \
                    unsigned tk = 0u; \
                    for (int bit = 31; bit >= 0; --bit) { const unsigned cand = tk | (1u << bit); unsigned cl = 0; \
_Pragma("unroll") \
                        for (int i = 0; i < NC_; ++i) { float vi = v[i]; asm volatile("" : "+v"(vi)); cl += (vi == vi && fkey(vi) >= cand) ? 1u : 0u; } \
                        int cnt = 0; \
_Pragma("unroll") \
                        for (int bb = 0; bb < 7; ++bb) cnt += (int)__builtin_popcountll(__ballot((cl >> bb) & 1u)) << bb; \
                        if (cnt >= DSA_TOPK) tk = cand; } \
                    const unsigned ub = (tk & 0x80000000u) ? (tk ^ 0x80000000u) : ~tk; thr = __uint_as_float(ub); \
                } \
            } \
            int mlo = 0, mhi = 0; \
_Pragma("unroll") \
            for (int g4 = 0; g4 < NC_ / 4; ++g4) { const u64 m0 = __ballot(v[4 * g4] >= thr), m1 = __ballot(v[4 * g4 + 1] >= thr), m2 = __ballot(v[4 * g4 + 2] >= thr), m3 = __ballot(v[4 * g4 + 3] >= thr); \
                asm volatile("s_nop 1\n\tv_writelane_b32 %0, %2, %10\n\tv_writelane_b32 %1, %3, %10\n\tv_writelane_b32 %0, %4, %11\n\tv_writelane_b32 %1, %5, %11\n\t" \
                             "v_writelane_b32 %0, %6, %12\n\tv_writelane_b32 %1, %7, %12\n\tv_writelane_b32 %0, %8, %13\n\tv_writelane_b32 %1, %9, %13" \
                             : "+v"(mlo), "+v"(mhi) : "s"((unsigned)m0), "s"((unsigned)(m0 >> 32)), "s"((unsigned)m1), "s"((unsigned)(m1 >> 32)), "s"((unsigned)m2), "s"((unsigned)(m2 >> 32)), \
                               "s"((unsigned)m3), "s"((unsigned)(m3 >> 32)), "n"(4 * g4), "n"(4 * g4 + 1), "n"(4 * g4 + 2), "n"(4 * g4 + 3)); } \
            mask[(size_t)(tok0 + wave) * 64 + lane] = ((u64)(unsigned)mhi << 32) | (unsigned)mlo; \
        }
__device__ __forceinline__ void p3_indexer(const Args& a, LAS unsigned char* lds, int vcu, int G, int wave, int lane, int tid) {
    unsigned char* ws = a.ws;
    {
        const f16* Ka = (const f16*)(ws + WS_QKV) + 1 * QKV_ONE; float* km = (float*)(ws + WS_KMEAN);
        LAS float* red = (LAS float*)lds;
        for (int it = vcu; it < BATCH * NH * (MOBA_NB - 1); it += G) {
            const int n = it % (MOBA_NB - 1), bh = it / (MOBA_NB - 1), rg = tid >> 4, cc = tid & 15;
            const f16* p = Ka + ((size_t)bh * SEQ + n * MOBA_BLOCK + rg) * HD + cc * 8;
            f16x8 v[8];
#pragma unroll
            for (int r = 0; r < 8; ++r) v[r] = *(const f16x8*)(p + (size_t)r * 32 * HD);
            float acc[8];
#pragma unroll
            for (int e = 0; e < 8; ++e) { acc[e] = 0.f;
#pragma unroll
                for (int r = 0; r < 8; ++r) acc[e] += (float)v[r][e]; }
            __syncthreads();
#pragma unroll
            for (int e = 0; e < 8; ++e) red[rg * 128 + cc * 8 + e] = acc[e];
            __syncthreads();
            if (tid < 128) { float sum = 0.f;
#pragma unroll
                for (int r = 0; r < 32; ++r) sum += red[r * 128 + tid];
                const int b = bh / NH, hh = bh % NH;
                km[((size_t)(b * MOBA_NB + n) * NH + hh) * HD + tid] = sum * (1.0f / MOBA_BLOCK); }
        }
        __syncthreads();
    }
    const f16* qidx = (const f16*)(ws + WS_QIDX); const f16* kidx = (const f16*)(ws + WS_KIDX); const float* widx = (const float*)(ws + WS_WIDX); u64* mask = (u64*)(ws + WS_MASK);
    LAS unsigned* sc = (LAS unsigned*)lds;
    const int r32 = lane & 31, hi = lane >> 5;
    f16x8 qa[4][4]; f16x8 kA[4], kB[4]; float wnext = 0.f;
    LAS float* wl = (LAS float*)(lds + 131072);
#define IDX_DECODE(uu_, b_, t0_, ntile_) const int kq_ = (uu_) >> 8, cq_ = (uu_) & 255; b_ = (kq_ >> 1) & 1; t0_ = ((kq_ & 1) ? 511 - cq_ : cq_) * 8; ntile_ = ((t0_ + 8 + 63) >> 6) << 1
#define IDX_LOAD_UNIT(uu_) do { int b_, t0_, nt_; IDX_DECODE(uu_, b_, t0_, nt_); const int tok0_ = b_ * SEQ + t0_; int r32 = lane & 31, hi = lane >> 5; asm volatile("" : "+v"(r32), "+v"(hi));                                       \
        _Pragma("unroll") for (int mt = 0; mt < 4; ++mt) { const int tok = tok0_ + 2 * mt + (r32 >> 4), head = r32 & 15;                               \
            _Pragma("unroll") for (int ks = 0; ks < 4; ++ks) qa[mt][ks] = *(const f16x8*)(qidx + (size_t)tok * (IDXH * IDXD) + head * IDXD + ks * 16 + hi * 8); } \
        if (tid < 128) wnext = widx[(size_t)tok0_ * IDXH + tid];                                                                                       \
        const f16* kb_ = kidx + (size_t)(b_ * SEQ + r32) * IDXD + hi * 8;                                                                              \
        if (wave < nt_) { _Pragma("unroll") for (int ks = 0; ks < 4; ++ks) kA[ks] = *(const f16x8*)(kb_ + (size_t)wave * 32 * IDXD + ks * 16); }       \
        if (wave + NWAVES < nt_) { _Pragma("unroll") for (int ks = 0; ks < 4; ++ks) kB[ks] = *(const f16x8*)(kb_ + (size_t)(wave + NWAVES) * 32 * IDXD + ks * 16); } } while (0)
#define RELU_(x) __builtin_amdgcn_fmed3f((x), 0.f, 3.0e38f)
#define IDX_TILE(KF, j_) do {                                                                                                                          \
        unsigned wa_ = (unsigned)(size_t)(wl + 4 * hi), sa_ = (unsigned)(size_t)(sc + hi * SEQ + (j_) * 32 + r32); asm volatile("" : "+v"(wa_), "+v"(sa_));     \
        const bool edge_ = (j_) * 32 + 31 > t0;                                                                                                         \
        _Pragma("unroll") for (int mt = 0; mt < 4; ++mt) { f32x16 c = {};                                                                              \
            const LAS f32x4* wp_ = (const LAS f32x4*)(size_t)wa_;                                                                                      \
            const f32x4 wa0 = wp_[(2 * mt) * 4], wa1 = wp_[(2 * mt) * 4 + 2], wb0 = wp_[(2 * mt + 1) * 4], wb1 = wp_[(2 * mt + 1) * 4 + 2];            \
            _Pragma("unroll") for (int ks = 0; ks < 4; ++ks) c = __builtin_amdgcn_mfma_f32_32x32x16_f16(qa[mt][ks], KF[ks], c, 0, 0, 0);               \
            float s0 = 0.f, s1 = 0.f;                                                                                                                  \
            _Pragma("unroll") for (int r = 0; r < 4; ++r) { s0 = fmaf(wa0[r], RELU_(c[r]), s0); s0 = fmaf(wa1[r], RELU_(c[4 + r]), s0);                 \
                                                          s1 = fmaf(wb0[r], RELU_(c[8 + r]), s1); s1 = fmaf(wb1[r], RELU_(c[12 + r]), s1); }            \
            auto rr = __builtin_amdgcn_permlane32_swap(__float_as_uint(s0), __float_as_uint(s1), false, false);                                        \
            unsigned sv = __float_as_uint(__uint_as_float(rr[0]) + __uint_as_float(rr[1]));     \
            if (edge_) sv = ((j_) * 32 + r32 <= t0 + 2 * mt + hi) ? sv : 0x7FC00000u;                                                                  \
            ((LAS unsigned*)(size_t)(sa_ + (mt >> 1) * 65536))[(mt & 1) * 2 * SEQ] = sv; } } while (0)
    if (vcu < 2 * 512) { IDX_LOAD_UNIT(vcu); if (tid < 128) wl[tid] = wnext; }
    __syncthreads();
    for (int uu = vcu; uu < 2 * 512; uu += G) {
        int b, t0, ntile; IDX_DECODE(uu, b, t0, ntile); const int tok0 = b * SEQ + t0;
        int r32o = r32, hio = hi; asm volatile("" : "+v"(r32o), "+v"(hio));
        const f16* kbase = kidx + (size_t)(b * SEQ + r32o) * IDXD + hio * 8;
        for (int q = 0; q < 8; ++q) for (int c4 = ntile * 8 + tid; c4 < SEQ / 4; c4 += NWAVES * 64) *(LAS u32x4*)(sc + q * SEQ + c4 * 4) = (u32x4){0x7FC00000u, 0x7FC00000u, 0x7FC00000u, 0x7FC00000u};
        {
        for (int j = wave; j < ntile; j += 2 * NWAVES) {
            f16x8 k0[4], k1[4];
#pragma unroll
            for (int ks = 0; ks < 4; ++ks) { k0[ks] = kA[ks]; k1[ks] = kB[ks]; }
            if (j + 2 * NWAVES < ntile) {
#pragma unroll
                for (int ks = 0; ks < 4; ++ks) kA[ks] = *(const f16x8*)(kbase + (size_t)(j + 2 * NWAVES) * 32 * IDXD + ks * 16);
            }
            if (j + 3 * NWAVES < ntile) {
#pragma unroll
                for (int ks = 0; ks < 4; ++ks) kB[ks] = *(const f16x8*)(kbase + (size_t)(j + 3 * NWAVES) * 32 * IDXD + ks * 16);
            }
            IDX_TILE(k0, j);
            if (j + NWAVES < ntile) IDX_TILE(k1, j + NWAVES);
        } }
        __syncthreads();
        if (uu + G < 2 * 512) { IDX_LOAD_UNIT(uu + G); }
        switch ((t0 + wave) >> 9) { case 0: SEL_BODY(8) break; case 1: SEL_BODY(16) break; case 2: SEL_BODY(24) break; case 3: SEL_BODY(32) break; case 4: SEL_BODY(40) break; case 5: SEL_BODY(48) break; case 6: SEL_BODY(56) break; default: SEL_BODY(64) break; }
        if (tid < 128) wl[tid] = wnext;
        __syncthreads();
    }
}
#undef SEL_BODY
#undef IDX_DECODE
#undef IDX_LOAD_UNIT
#undef IDX_TILE
#undef RELU_

__device__ __forceinline__ void moba_select(const f16* Q, const float* km_bh  , int qb, LAS unsigned* selm, LAS float* kml, int tid) {
    for (int i = tid; i < 15 * HD; i += NWAVES * 64) { const int n = i >> 7, d = i & 127; kml[i] = (n < qb) ? km_bh[(size_t)n * NH * HD + d] : 0.f; }
    __syncthreads();
    const int q = tid >> 1, half = tid & 1;
    float gsc[15];
#pragma unroll
    for (int n = 0; n < 15; ++n) gsc[n] = 0.f;
    const f16* qp = Q + (size_t)q * HD + half * 64;
#pragma unroll
    for (int c = 0; c < 8; ++c) { const f16x8 qv = *(const f16x8*)(qp + c * 8);
#pragma unroll
        for (int n = 0; n < 15; ++n) { const LAS f32x4* kp = (const LAS f32x4*)(kml + n * HD + half * 64 + c * 8); const f32x4 k0 = kp[0], k1 = kp[1];
#pragma unroll
            for (int e = 0; e < 4; ++e) { gsc[n] = fmaf((float)qv[e], k0[e], gsc[n]); gsc[n] = fmaf((float)qv[4 + e], k1[e], gsc[n]); } } }
    unsigned m = 0;
#pragma unroll
    for (int n = 0; n < 15; ++n) gsc[n] += __shfl_xor(gsc[n], 1);
#pragma unroll
    for (int pass = 0; pass < MOBA_TOPK; ++pass) { float best = -__builtin_inff(); int bi = -1;
#pragma unroll
        for (int n = 0; n < 15; ++n) { const bool ok = (n < qb) && !((m >> n) & 1u) && (gsc[n] > best); if (ok) { best = gsc[n]; bi = n; } }
        if (bi >= 0) m |= 1u << bi; }
    if (half == 0) selm[q] = m;
    __syncthreads();
}
__device__ __forceinline__ void p4_attention(const Args& a, LAS unsigned char* ldsl, char* lds, int vcu, int G, int tid) {
    unsigned char* ws = a.ws;
    const f16* qkv = (const f16*)(ws + WS_QKV); f16* Obase = (f16*)(ws + WS_H); const u64* mask = (const u64*)(ws + WS_MASK); const float* km = (const float*)(ws + WS_KMEAN);
    LAS unsigned* selm = (LAS unsigned*)(ldsl + att::LDS_SELM); LAS float* kml = (LAS float*)(ldsl + att::LDS_KM);
    unsigned* ctr = (unsigned*)(ws + WS_CTL) + CW_QUEUE; LAS int* nxt = (LAS int*)(ldsl + LDSCTL_OFF + 64);
    for (;;) {
        __syncthreads();
        if (tid == 0) *nxt = (int)__hip_atomic_fetch_add(ctr, 1u, RLX_AGENT);
        __syncthreads();
        const int j = *nxt; if (j >= 512) break;
        const int qb = 15 - (j >> 5), kind = ((j >> 4) & 1) ^ 1, bh = j & 15, b = bh >> 3, h = bh & 7;
        const size_t hoff = (size_t)(b * NH + h) * SEQ * HD;
        const f16* Q = qkv + (size_t)(kind * 3 + 0) * QKV_ONE + hoff; const f16* K = qkv + (size_t)(kind * 3 + 1) * QKV_ONE + hoff; const f16* V = qkv + (size_t)(kind * 3 + 2) * QKV_ONE + hoff;
        f16* O = Obase + (size_t)kind * QKV_ONE + (size_t)b * SEQ * AW + h * HD;
        att::BlockRef r;
        r.Q = Q + (size_t)qb * 256 * HD; r.K = K; r.V = V; r.O = O + (size_t)qb * 256 * AW; r.P0 = qb * 256; r.M = mask + ((size_t)b * SEQ + qb * 256) * 64; r.sel = (const unsigned*)(lds + att::LDS_SELM);
        if (kind == 0) { moba_select(r.Q, km + ((size_t)(b * MOBA_NB) * NH + h) * HD, qb, selm, kml, tid); att::attn_block<0, true>(r, lds); }
        else { att::attn_block<1, true>(r, lds); }
    }
    asm volatile("s_waitcnt vmcnt(0)" ::: "memory"); __syncthreads();
}

__global__ void __launch_bounds__(NWAVES * 64, 2) mk_fwd(Args args) {
    extern __shared__ __attribute__((aligned(16))) unsigned char lds[];
    LAS unsigned char* ldsl = (LAS unsigned char*)lds;
    volatile LAS unsigned* MISC = (volatile LAS unsigned*)(ldsl + MISC_OFF);
    const int tid = threadIdx.x, lane = tid & 63, wave = __builtin_amdgcn_readfirstlane(tid >> 6);
    const int G = gridDim.x; int vcu; { const int bx = blockIdx.x; vcu = (G % 8 == 0) ? (bx % 8) * (G / 8) + bx / 8 : bx; }
    unsigned char* ws = args.ws;
    gu32* ctl = (gu32*)(ws + WS_CTL);
    for (int u = tid; u < (LDS_BYTES - LDSCTL_OFF) / 4; u += NWAVES * 64) ((LAS unsigned*)(ldsl + LDSCTL_OFF))[u] = 0u;
    __syncthreads();
    if (tid == 0) { LAS u64* pt = (LAS u64*)(ldsl + PTRTAB_OFF);
        pt[0] = (u64)args.in[0]; pt[1] = (u64)args.in[3]; pt[2] = (u64)args.in[5]; pt[3] = (u64)args.in[10]; pt[4] = (u64)args.in[11]; pt[5] = (u64)args.out; pt[6] = (u64)args.ws;
        pt[7] = (u64)args.in[6]; pt[8] = (u64)args.in[7]; pt[9] = (u64)args.in[8]; pt[10] = (u64)args.in[9]; pt[11] = (u64)args.in[12]; pt[12] = (u64)args.in[13]; }
    __syncthreads();
    XcdBarrier bar; bar.bar = (unsigned*)(ctl + CW_BAR); bar.x = 0; bar.st = nullptr;
    if (MK_N_LAUNCHES == 1) bar = xcd_barrier_post((unsigned*)(ctl + CW_BAR), MISC + 8);
    const int lo = args.ph_lo, hi = args.ph_hi;
#define IN(k) (lo <= (k) && (k) < hi)
#define SEAM(k) do { if (IN(k) && IN((k) + 1)) xcd_barrier(bar); } while (0)
    if (IN(0)) { p0_prologue(args, ldsl, vcu, G, wave, lane, tid); } SEAM(0);
    if (IN(1)) { p1_norm_in(args, ldsl, vcu, G, wave, lane, tid); } SEAM(1);
    if (IN(2)) {
        { pg8::Gemm g{(const f16*)(ws + WS_H), (const f16*)(ws + WS_WIN), nullptr, nullptr, DM};
          pg8::StaticOrder S; S.init(MTOK, N_IN16, G, (int)blockIdx.x);
          pg8::EpiIn E{(f16*)(ws + WS_QKV), (f16*)(ws + WS_QIDX), (f16*)(ws + WS_KIDX), (float*)(ws + WS_WIDX), (f16*)(ws + WS_GA), (f16*)(ws + WS_GB), (const float*)(ws + WS_ROPEA), (const float*)(ws + WS_ROPEB), 0};
          pg8::gemm_phase<pg8::EpiIn, pg8::StaticOrder, true>(ldsl, g, S, E); }
        { pg8::Gemm g{(const f16*)(ws + WS_H8), (const f16*)(ws + WS_WG8), nullptr, nullptr, DM};
          pg8::StaticOrder S; S.init(MTOK, N_IN8, G, (int)blockIdx.x);
          pg8::EpiIn E{(f16*)(ws + WS_QKV), (f16*)(ws + WS_QIDX), (f16*)(ws + WS_KIDX), (float*)(ws + WS_WIDX), (f16*)(ws + WS_GA), (f16*)(ws + WS_GB), (const float*)(ws + WS_ROPEA), (const float*)(ws + WS_ROPEB), 1};
          pg8::gemm_phase<pg8::EpiIn, pg8::StaticOrder, true, true, 0x7F7F7F7F, 0x77777777, true>(ldsl, g, S, E); }
        if (CONV_SPLIT < CONV_TOTAL) {
            const int rem = ((MTOK / 256) * (N_IN16 / 256)) % G, wi = rem ? (int)blockIdx.x - rem : (int)blockIdx.x, nw = rem ? G - rem : G;
            if (wi >= 0) conv_items(ws, ldptr(ldsl, 7), ldptr(ldsl, 8), ldptr(ldsl, 9), ldptr(ldsl, 10), ldptr(ldsl, 11), ldptr(ldsl, 12), ldsl, CONV_SPLIT, CONV_TOTAL, wi * NWAVES + wave, nw * NWAVES, wave, lane); }
    } SEAM(2);
    if (IN(3)) { p3_indexer(args, ldsl, vcu, G, wave, lane, tid); } SEAM(3);
    if (IN(4)) { p4_attention(args, ldsl, (char*)lds, vcu, G, tid); } SEAM(4);
    if (IN(5)) {
        pg8::Gemm g{(const f16*)(ws + WS_H), (const f16*)(ws + WS_WMO), (const f16*)(ws + WS_H) + QKV_ONE, (const f16*)(ws + WS_WDO), AW};
        pg8::StaticOrder S; S.init(MTOK, DM, G, (int)blockIdx.x, 2);
        pg8::EpiOut E{(const f16*)(ws + WS_GA), (const f16*)(ws + WS_GB), (unsigned char*)(ws + WS_QKV)};
        pg8::gemm_phase<pg8::EpiOut, pg8::StaticOrder, true>(ldsl, g, S, E);
    } SEAM(5);
    if (IN(6)) {
        pg8::Gemm g{(const f16*)(ws + WS_QKV), (const f16*)(ws + WS_WO), nullptr, nullptr, DM};
        pg8::StaticOrder S; S.init(MTOK, DM, G, (int)blockIdx.x);
        pg8::EpiSq E{(f16*)(ws + WS_QKV + 32 * MiB), (float*)(ws + WS_SSP1)};
        pg8::gemm_phase<pg8::EpiSq, pg8::StaticOrder, false, true, 0x7B7B7B7B, 0x77777777, true>(ldsl, g, S, E);
    } SEAM(6);
    if (IN(7)) { int t2 = threadIdx.x; asm volatile("" : "+v"(t2)); p7_mid(args, ldsl, vcu, G, __builtin_amdgcn_readfirstlane(t2 >> 6), t2 & 63, t2); } SEAM(7);
    if (IN(8)) {
        pg8::Gemm g{(const f16*)(ws + WS_H), (const f16*)(ws + WS_W1), nullptr, nullptr, DM};
        pg8::StaticOrder S; S.init(MTOK, FF, G, (int)blockIdx.x);
        pg8::EpiRelu2 E{(unsigned char*)(ws + WS_U)};
        pg8::gemm_phase<pg8::EpiRelu2, pg8::StaticOrder, true, false, 0x7F7F7F7F, 0x7F7F7F7F, true>(ldsl, g, S, E);
    } SEAM(8);
    if (IN(9)) {
        pg8::Gemm g{(const f16*)(ws + WS_U), (const f16*)(ws + WS_W2), nullptr, nullptr, FF};
        pg8::StaticOrder S; S.init(MTOK, DM, G, (int)blockIdx.x);
        pg8::EpiSq E{(f16*)(ws + WS_F), (float*)(ws + WS_SSP2)};
        pg8::gemm_phase<pg8::EpiSq, pg8::StaticOrder, false, true, 0x7F7F7F7F, 0x77777777, true>(ldsl, g, S, E);
    } SEAM(9);
    if (IN(10)) { int t2 = threadIdx.x; asm volatile("" : "+v"(t2)); p10_final(args, ldsl, vcu, G, __builtin_amdgcn_readfirstlane(t2 >> 6), t2 & 63, t2); }
#undef IN
#undef SEAM
}

extern "C" void kernel_launch(void* const* d_in, const int* in_sizes, int n_in, void* d_out, int out_size, void* d_ws, size_t ws_size, hipStream_t stream) {
    static int grid = 0;
    if (grid == 0) {
        if (n_in != 14 || out_size != MTOK * DM || ws_size < WS_END) { fprintf(stderr, "kernel_launch: unexpected shapes (n_in %d out %d ws %zu)\n", n_in, out_size, ws_size); grid = -1; return; }
        int dev = 0, cus = 0;
        if (hipGetDevice(&dev) != hipSuccess || hipDeviceGetAttribute(&cus, hipDeviceAttributeMultiprocessorCount, dev) != hipSuccess) { grid = -1; return; }
        if (hipFuncSetAttribute((const void*)mk_fwd, hipFuncAttributeMaxDynamicSharedMemorySize, LDS_BYTES) != hipSuccess) { fprintf(stderr, "kernel_launch: hipFuncSetAttribute failed\n"); grid = -1; return; }
        int per_cu = 0;
        if (hipOccupancyMaxActiveBlocksPerMultiprocessor(&per_cu, (const void*)mk_fwd, NWAVES * 64, LDS_BYTES) != hipSuccess || per_cu < 1) { fprintf(stderr, "kernel_launch: occupancy query says %d\n", per_cu); }
        (void)hipGetLastError();
        grid = cus;
    }
    if (grid < 0) return;
    (void)hipMemsetAsync((char*)d_ws + WS_CTL, 0, CTL_ZERO_BYTES, stream);
    Args a{};
    for (int i = 0; i < 14; ++i) a.in[i] = (const float*)d_in[i];
    a.out = (float*)d_out; a.ws = (unsigned char*)d_ws;
    if (MK_N_LAUNCHES == 1) {
        a.ph_lo = 0; a.ph_hi = NPHASE;
        hipLaunchKernelGGL(mk_fwd, dim3(grid), dim3(NWAVES * 64), LDS_BYTES, stream, a);
    } else {
        for (int p = 0; p < NPHASE; ++p) { a.ph_lo = p; a.ph_hi = p + 1;
            for (int r = 0; r < (((MK_DOUBLE_MASK >> p) & 1) ? 2 : 1); ++r) hipLaunchKernelGGL(mk_fwd, dim3(grid), dim3(NWAVES * 64), LDS_BYTES, stream, a); }
    }
}
```

```cpp
#include <hip/hip_runtime.h>
#include <cstdio>
#include <cstdint>

#ifndef MK_N_LAUNCHES
#define MK_N_LAUNCHES 1
#endif

#ifndef MK_DOUBLE_MASK
#define MK_DOUBLE_MASK 0
#endif
#define LAS __attribute__((address_space(3)))
#define GAS __attribute__((address_space(1)))
typedef _Float16 f16;
typedef _Float16 f16x8 __attribute__((ext_vector_type(8)));
typedef _Float16 f16x4 __attribute__((ext_vector_type(4)));
typedef _Float16 f16x2 __attribute__((ext_vector_type(2)));
typedef float f32x2 __attribute__((ext_vector_type(2)));
typedef float f32x4 __attribute__((ext_vector_type(4)));
typedef float f32x16 __attribute__((ext_vector_type(16)));
typedef unsigned u32x2 __attribute__((ext_vector_type(2)));
typedef unsigned u32x4 __attribute__((ext_vector_type(4)));
typedef int i32x4 __attribute__((ext_vector_type(4)));
typedef int i32x8 __attribute__((ext_vector_type(8)));
typedef short s16x4 __attribute__((ext_vector_type(4)));
typedef unsigned long long u64;

constexpr int BATCH = 2, SEQ = 4096, DM = 2048, MTOK = BATCH * SEQ, NH = 8, HD = 128, AW = NH * HD, FF = 8192;
constexpr int IDXH = 16, IDXD = 64, DSA_TOPK = 256, MOBA_BLOCK = 256, MOBA_NB = SEQ / MOBA_BLOCK, MOBA_TOPK = 3;
constexpr int D_IN = 11344, N_IN_PAD = 11520;
constexpr int N_IN16 = 21 * 256, N_IN8 = 24 * 256;
constexpr int C_QI = 6144, C_KI = 7168, C_WI = 7232, C_GA = 7248, C_GB = 9296;
constexpr float RMS_EPS = 1e-6f;

constexpr size_t MiB = 1u << 20;
constexpr size_t WS_CTL = 0, CTL_ZERO_BYTES = 64 * 1024;
constexpr size_t WS_KMEAN = 1 * MiB;
constexpr size_t WS_MODF = 1 * MiB + 256 * 1024;
constexpr size_t WS_MODP = 2 * MiB;
constexpr size_t WS_SSP1 = 5 * MiB, WS_SSP2 = 6 * MiB;
constexpr size_t WS_ROPEA = 7 * MiB;
constexpr size_t WS_ROPEB = 9 * MiB;
constexpr size_t WS_WIDX = 10 * MiB;
constexpr size_t WS_KIDX = 10 * MiB + 512 * 1024;
constexpr size_t WS_MASK = 12 * MiB;
constexpr size_t WS_WIN = 16 * MiB;
constexpr size_t WS_WMO = 61 * MiB, WS_WDO = 65 * MiB, WS_WO = 69 * MiB, WS_W1 = 77 * MiB, WS_W2 = 109 * MiB;
constexpr size_t WS_H = 141 * MiB;
constexpr size_t WS_QKV = 173 * MiB;
constexpr size_t WS_QIDX = 269 * MiB;
constexpr size_t WS_GA = 285 * MiB, WS_GB = 317 * MiB;
constexpr size_t WS_U = 173 * MiB;
constexpr size_t WS_F = 301 * MiB;
constexpr size_t WS_H8 = 125 * MiB;
constexpr size_t WS_WG8 = 349 * MiB;
constexpr size_t WS_END = 361 * MiB;
constexpr size_t QKV_ONE = (size_t)MTOK * AW;

constexpr int NPHASE = 11;

__device__ __forceinline__ unsigned pkh(float lo, float hi) { f32x2 v = {lo, hi}; f16x2 h = __builtin_convertvector(v, f16x2); return __builtin_bit_cast(unsigned, h); }
__device__ __forceinline__ f32x2 unpkh(unsigned w) { f16x2 h = __builtin_bit_cast(f16x2, w); return __builtin_convertvector(h, f32x2); }
__device__ __forceinline__ float wave_sum(float v) {
#pragma unroll
    for (int o = 1; o < 64; o <<= 1) v += __shfl_xor(v, o);
    return v;
}
__device__ __forceinline__ float sigmoidf_(float x) { return __builtin_amdgcn_rcpf(1.0f + __builtin_amdgcn_exp2f(-1.4426950408889634f * x)); }
#define LDS_WAIT() asm volatile("s_waitcnt lgkmcnt(0)" ::: "memory")
#define VM_WAIT() asm volatile("s_waitcnt vmcnt(0)" ::: "memory")

namespace pg8 {
constexpr int BM = 256, BK = 64, HALF = 128, HTB = HALF * BK * 2, STAGE_BYTES = 8 * HTB, NXCD = 8, WGM = 8;
__host__ __device__ __forceinline__ int lds_byte(int r, int c) { const int st = (r >> 4) * 2 + (c >> 5), rr = r & 15, cc = c & 31, ob = rr * 64 + cc * 2; return st * 1024 + (ob ^ (((ob >> 9) & 1) << 5)); }
__host__ __device__ __forceinline__ void stage_rc(int b, int& R, int& C) { const int st = b / 1024, sb = b % 1024, swz = sb ^ (((sb >> 9) & 1) << 5); R = (st >> 1) * 16 + swz / 64; C = (st & 1) * 32 + (swz % 64) / 2; }
__host__ __device__ __forceinline__ int perm32(int rho) { const int n = rho >> 4, i = rho & 15; return 8 * (i >> 2) + 4 * n + (i & 3); }

struct Unit { int pm, pn, z; };
struct Gemm { const f16* A0; const f16* B0; const f16* A1; const f16* B1; int K; };

struct StaticOrder {
    int nM, nN, nwg, G, c, nz;
    __device__ void init(int M, int N, int G_, int c_, int nz_ = 1) { nM = M / BM; nN = N / BM; nwg = nM * nN; G = G_; c = c_; nz = nz_; }
    __device__ bool next(int i, Unit& u) const {
        const int it = i / nz; u.z = i - it * nz;
        const long L = (long)it * G + c; if (L >= nwg) return false;
        int wgid = (int)L; { const int q = nwg / NXCD, r = nwg % NXCD, xcd = wgid % NXCD, off = wgid / NXCD; wgid = (xcd < r ? xcd * (q + 1) : r * (q + 1) + (xcd - r) * q) + off; }
        const int nig = WGM * nN, gid = wgid / nig, fm = gid * WGM, gsz = (nM - fm) < WGM ? (nM - fm) : WGM;
        u.pm = fm + ((wgid % nig) % gsz); u.pn = (wgid % nig) / gsz; return true;
    }
};

template <class Epi, class Sched, bool ALIGN_EPI, bool F8 = false, int SCL_A = 0x7F7F7F7F, int SCL_B = 0x7F7F7F7F, bool ZI = false>
__device__ __forceinline__ void gemm_phase(LAS unsigned char* lds, const Gemm g, const Sched& S, const Epi& E) {
    const int tid = threadIdx.x, wid = __builtin_amdgcn_readfirstlane(tid >> 6), lane = tid & 63, wr = wid >> 2, wc = wid & 3, fr = lane & 15, fq = lane >> 4;
    const int K = g.K, Kb = F8 ? K : 2 * K  , nt = Kb / (2 * BK);
    unsigned voffA[2], voffB[2], voffB1[2];
#pragma unroll
    for (int i = 0; i < 2; ++i) { int R, C; stage_rc(tid * 16 + i * 8192, R, C); const int Rb = (R & ~31) + perm32(R & 31);
        voffA[i] = (unsigned)(R * Kb + C * 2);
        if constexpr (Epi::PERM256) { const int wq = R >> 5, n_ = (R >> 4) & 1, i_ = R & 15, r0 = 64 * wq + 16 * (i_ >> 2) + 4 * n_ + (i_ & 3);
            voffB[i] = (unsigned)(r0 * Kb + C * 2); voffB1[i] = (unsigned)((r0 + 8) * Kb + C * 2); }
        else { voffB[i] = (unsigned)(Rb * Kb + C * 2); voffB1[i] = voffB[i] + (unsigned)(HALF * Kb); } }
    const size_t kstep = (size_t)(BK * 2);
    const size_t hstep = (size_t)HALF * Kb;
    const size_t tstep = 2 * hstep;
    const unsigned ldsw = (unsigned)wid * 1024u;
    const int aoff = lds_byte(wr * 64 + fr, F8 ? fq * 16 : fq * 8), boff = lds_byte(wc * 32 + fr, F8 ? fq * 16 : fq * 8);
#define PG8_SA(b, h) (((b) * 2 + (h)) * HTB)
#define PG8_SB(b, h) ((4 + (b) * 2 + (h)) * HTB)
#define PG8_STAGE(bufoff, gbase, voff) do { _Pragma("unroll") for (int _i = 0; _i < 2; ++_i) \
        __builtin_amdgcn_global_load_lds((const unsigned*)((const char*)(gbase) + (voff)[_i]), (LAS unsigned*)(lds + (bufoff) + ldsw + _i * 8192), 16, 0, 0); } while (0)
#define PG8_KOFF(k) (F8 ? (k) * 16 : (k) * 1024)
#define PG8_LDA(dst, b, h) do { _Pragma("unroll") for (int m = 0; m < 4; ++m) _Pragma("unroll") for (int k = 0; k < 2; ++k) dst[m][k] = *(const LAS f16x8*)(lds + PG8_SA(b, h) + aoff + m * 2048 + PG8_KOFF(k)); } while (0)
#define PG8_LDB(dst, b, h) do { _Pragma("unroll") for (int n = 0; n < 2; ++n) _Pragma("unroll") for (int k = 0; k < 2; ++k) dst[n][k] = *(const LAS f16x8*)(lds + PG8_SB(b, h) + boff + n * 2048 + PG8_KOFF(k)); } while (0)
#define PG8_F8(x) __builtin_shufflevector(__builtin_bit_cast(i32x4, x[0]), __builtin_bit_cast(i32x4, x[1]), 0, 1, 2, 3, 4, 5, 6, 7)
      \
#define PG8_MMA(ai, bj, At, Bt, Z) do { __builtin_amdgcn_s_setprio(1); _Pragma("unroll") for (int m = 0; m < 4; ++m) _Pragma("unroll") for (int n = 0; n < 2; ++n) { \
        if constexpr (F8) { const i32x8 b8_ = PG8_F8(Bt[n]), a8_ = PG8_F8(At[m]);     \
            if constexpr (Z) asm volatile("v_mfma_scale_f32_16x16x128_f8f6f4 %0, %1, %2, 0, %3, %4 op_sel_hi:[0,0,0]" : "=&v"(acc[ai][bj][m][n]) : "v"(b8_), "v"(a8_), "v"(sclB_), "v"(sclA_)); \
            else asm volatile("v_mfma_scale_f32_16x16x128_f8f6f4 %0, %1, %2, %0, %3, %4 op_sel_hi:[0,0,0]" : "+v"(acc[ai][bj][m][n]) : "v"(b8_), "v"(a8_), "v"(sclB_), "v"(sclA_)); } \
        else { if constexpr (Z) acc[ai][bj][m][n] = __builtin_amdgcn_mfma_f32_16x16x32_f16(Bt[n][0], At[m][0], (f32x4){0.f, 0.f, 0.f, 0.f}, 0, 0, 0); \
               else acc[ai][bj][m][n] = __builtin_amdgcn_mfma_f32_16x16x32_f16(Bt[n][0], At[m][0], acc[ai][bj][m][n], 0, 0, 0); \
               acc[ai][bj][m][n] = __builtin_amdgcn_mfma_f32_16x16x32_f16(Bt[n][1], At[m][1], acc[ai][bj][m][n], 0, 0, 0); } } \
        __builtin_amdgcn_s_setprio(0); } while (0)
#define PG8_WAIT_V(n) asm volatile("s_waitcnt vmcnt(" #n ")" ::: "memory")
#define PG8_WAIT_L(n) asm volatile("s_waitcnt lgkmcnt(" #n ")" ::: "memory")
#define PG8_BAR __builtin_amdgcn_s_barrier()
#define PG8_SCHED __builtin_amdgcn_sched_barrier(0)
    constexpr bool ZINIT = ZI && !Epi::KEEPS;
    Unit cur, nxt; int ui = 0;
    if (!S.next(0, cur)) return;
    f32x4 acc[2][2][4][2];
#pragma unroll
    for (int a = 0; a < 2; ++a)
#pragma unroll
        for (int b = 0; b < 2; ++b)
#pragma unroll
            for (int m = 0; m < 4; ++m)
#pragma unroll
                for (int n = 0; n < 2; ++n) acc[a][b][m][n] = (f32x4){0.f, 0.f, 0.f, 0.f};
    f16x8 At[4][2], B0[2][2], B1[2][2];
    const int sclA_ = SCL_A, sclB_ = SCL_B; (void)sclA_; (void)sclB_;
    const char* cA = (const char*)(cur.z ? g.A1 : g.A0) + (size_t)cur.pm * tstep; const char* cB = (const char*)(cur.z ? g.B1 : g.B0) + (size_t)cur.pn * tstep;
    PG8_STAGE(PG8_SB(0, 0), cB, voffB); PG8_STAGE(PG8_SB(0, 1), cB, voffB1); PG8_STAGE(PG8_SA(0, 0), cA, voffA); PG8_STAGE(PG8_SA(0, 1), cA + hstep, voffA);
    if (wr == 1) PG8_BAR;
    PG8_WAIT_V(2); PG8_BAR;
    PG8_STAGE(PG8_SB(1, 0), cB + kstep, voffB); PG8_STAGE(PG8_SA(1, 0), cA + kstep, voffA); PG8_STAGE(PG8_SB(1, 1), cB + kstep, voffB1);
    PG8_WAIT_V(6); PG8_BAR;
    for (;;) {
        const bool has_next = S.next(ui + 1, nxt);
        const char* nA = has_next ? (const char*)(nxt.z ? g.A1 : g.A0) + (size_t)nxt.pm * tstep : cA; const char* nB = has_next ? (const char*)(nxt.z ? g.B1 : g.B0) + (size_t)nxt.pn * tstep : cB;
#define PG8_BODY(Z) do { \
            const bool last = (t == nt - 2); \
            const char* a1 = cA + (size_t)(t + 1) * kstep; \
            const char* a2 = last ? nA : cA + (size_t)(t + 2) * kstep; const char* b2 = last ? nB : cB + (size_t)(t + 2) * kstep; \
            const char* a3 = a2 + kstep; const char* b3 = b2 + kstep; \
            PG8_LDB(B0, 0, 0); PG8_LDB(B1, 0, 1); PG8_SCHED; PG8_LDA(At, 0, 0); PG8_STAGE(PG8_SA(1, 1), a1 + hstep, voffA); \
            PG8_WAIT_V(8); PG8_WAIT_L(0); PG8_BAR; PG8_MMA(0, 0, At, B0, Z); PG8_MMA(0, 1, At, B1, Z); PG8_BAR; PG8_SCHED; \
            PG8_LDA(At, 0, 1); PG8_STAGE(PG8_SB(0, 0), b2, voffB); PG8_STAGE(PG8_SB(0, 1), b2, voffB1); PG8_STAGE(PG8_SA(0, 0), a2, voffA); \
            PG8_WAIT_V(8); PG8_WAIT_L(0); PG8_BAR; PG8_MMA(1, 0, At, B0, Z); PG8_MMA(1, 1, At, B1, Z); PG8_BAR; PG8_SCHED; \
            PG8_LDB(B0, 1, 0); PG8_LDB(B1, 1, 1); PG8_SCHED; PG8_LDA(At, 1, 0); PG8_STAGE(PG8_SA(0, 1), a2 + hstep, voffA); \
            PG8_WAIT_V(8); PG8_WAIT_L(0); PG8_BAR; PG8_MMA(0, 0, At, B0, false); PG8_MMA(0, 1, At, B1, false); PG8_BAR; PG8_SCHED; \
            PG8_LDA(At, 1, 1); PG8_STAGE(PG8_SB(1, 0), b3, voffB); PG8_STAGE(PG8_SB(1, 1), b3, voffB1); PG8_STAGE(PG8_SA(1, 0), a3, voffA); \
            PG8_WAIT_V(8); PG8_WAIT_L(0); PG8_BAR; PG8_MMA(1, 0, At, B0, false); PG8_MMA(1, 1, At, B1, false); PG8_BAR; PG8_SCHED; } while (0)
        if constexpr (ZINIT) { { const int t = 0; PG8_BODY(true); }
            for (int t = 2; t < nt; t += 2) PG8_BODY(false); }
        else { for (int t = 0; t < nt; t += 2) PG8_BODY(false); }
        if constexpr (ALIGN_EPI) { if (wr == 0) PG8_BAR; }
        if constexpr (F8) asm volatile("s_nop 15\n\ts_nop 15" ::: "memory");
        { int t2 = threadIdx.x; asm volatile("" : "+v"(t2));
          const int w2 = __builtin_amdgcn_readfirstlane(t2 >> 6), l2 = t2 & 63; E(acc, cur, w2 >> 2, w2 & 3, l2 & 15, l2 >> 4); }
        if (!has_next) break;
        if (!ZINIT && !E.keep(cur)) {
#pragma unroll
        for (int a = 0; a < 2; ++a)
#pragma unroll
            for (int b = 0; b < 2; ++b)
#pragma unroll
                for (int m = 0; m < 4; ++m)
#pragma unroll
                    for (int n = 0; n < 2; ++n) acc[a][b][m][n] = (f32x4){0.f, 0.f, 0.f, 0.f};
        }
        cur = nxt; cA = nA; cB = nB; ++ui;
        if constexpr (ALIGN_EPI) { if (wr == 1) PG8_BAR; }
    }
    PG8_WAIT_V(0);
    if constexpr (!ALIGN_EPI) { if (wr == 0) PG8_BAR; }
    PG8_BAR;
#undef PG8_SA
#undef PG8_SB
#undef PG8_STAGE
#undef PG8_LDA
#undef PG8_LDB
#undef PG8_MMA
#undef PG8_BODY
#undef PG8_F8
#undef PG8_KOFF
#undef PG8_WAIT_V
#undef PG8_WAIT_L
#undef PG8_BAR
#undef PG8_SCHED
}

typedef f32x4 AccT[2][2][4][2];
__device__ __forceinline__ void st8h(f16* p, const f32x4& a, const f32x4& b) { u32x4 w; w.x = pkh(a[0], a[1]); w.y = pkh(a[2], a[3]); w.z = pkh(b[0], b[1]); w.w = pkh(b[2], b[3]); *(u32x4*)p = w; }

struct EpiIn {
    static constexpr bool PERM256 = false, KEEPS = false;
    f16* qkv; f16* qidx; f16* kidx; float* widx; f16* ga; f16* gb; const float* ropeA; const float* ropeB; int mode;
    __device__ __forceinline__ bool keep(const Unit&) const { return false; }
    static __device__ __forceinline__ void rope8(const f32x4& a0, const f32x4& a1, const f32x4& b0, const f32x4& b1, const f32x4& c0, const f32x4& c1, const f32x4& c2, const f32x4& c3, f16* dlo, f16* dhi) {
        const f32x4 o1a = a0 * c0 - b0 * c1, o2a = b0 * c0 + a0 * c1, o1b = a1 * c2 - b1 * c3, o2b = b1 * c2 + a1 * c3;
        st8h(dlo, o1a, o1b); st8h(dhi, o2a, o2b);
    }
    template <class F>
    static __device__ __forceinline__ void rope_tile(AccT& acc, int row0, const float* tab, int tw, int dlo, int hoff, F dstf) {
        f32x4 cs[2][2][4];
#define ROPE_LD(q_, buf_) do { _Pragma("unroll") for (int mm = 0; mm < 2; ++mm) { const int t = (row0 + ((q_) >> 1) * HALF + (((q_) & 1) * 2 + mm) * 16) & (SEQ - 1); const float* cp = tab + ((size_t)t * tw + dlo) * 2; \
            _Pragma("unroll") for (int i = 0; i < 4; ++i) cs[buf_][mm][i] = *(const f32x4*)(cp + 4 * i); } } while (0)
#define ROPE_DO(q_, buf_) do { _Pragma("unroll") for (int mm = 0; mm < 2; ++mm) { const int ai = (q_) >> 1, m = ((q_) & 1) * 2 + mm; f16* dst = dstf(row0 + ai * HALF + m * 16); \
            rope8(acc[ai][0][m][0], acc[ai][0][m][1], acc[ai][1][m][0], acc[ai][1][m][1], cs[buf_][mm][0], cs[buf_][mm][1], cs[buf_][mm][2], cs[buf_][mm][3], dst, dst + hoff); } } while (0)
        ROPE_LD(0, 0); ROPE_LD(1, 1); ROPE_DO(0, 0); ROPE_LD(2, 0); ROPE_DO(1, 1); ROPE_LD(3, 1); ROPE_DO(2, 0); ROPE_DO(3, 1);
#undef ROPE_LD
#undef ROPE_DO
    }
    __device__ __forceinline__ void operator()(AccT& acc, const Unit& u, int wr, int wc, int fr, int fq) const {
        const int p_ = u.pn; const int pn = mode == 0 ? (p_ < 8 ? p_ : (p_ < 16 ? p_ + 4 : p_ + 8)) : (p_ < 4 ? 8 + p_ : (p_ < 8 ? 16 + p_ : 21 + p_));
        const int row0 = u.pm * BM + wr * 64 + fr;
        if (pn < 24) {
            const int kind6 = pn >> 2, hp = pn & 3; f16* base = qkv + (size_t)kind6 * QKV_ONE;
            if ((kind6 % 3) != 2) {
                const int head = 2 * hp + (wc >> 1), dlo = 32 * (wc & 1) + 8 * fq;
                rope_tile(acc, row0, ropeA, 64, dlo, 64, [&](int row) { const int b = row >> 12, t = row & (SEQ - 1); return base + ((size_t)(b * NH + head) * SEQ + t) * HD + dlo; });
            } else {
#pragma unroll
                for (int ai = 0; ai < 2; ++ai)
#pragma unroll
                    for (int m = 0; m < 4; ++m) { const int row = row0 + ai * HALF + m * 16, b = row >> 12, t = row & (SEQ - 1);
#pragma unroll
                        for (int bj = 0; bj < 2; ++bj) { f16* dst = base + ((size_t)(b * NH + 2 * hp + bj) * SEQ + t) * HD + 32 * wc + 8 * fq; st8h(dst, acc[ai][bj][m][0], acc[ai][bj][m][1]); } }
            }
        } else if (pn < 28) {
            const int head = 4 * (pn - 24) + wc, dlo = 8 * fq;
            rope_tile(acc, row0, ropeB, 32, dlo, 32, [&](int row) { return qidx + (size_t)row * (IDXH * IDXD) + head * IDXD + dlo; });
        } else if (pn == 28) {
            if (wc == 0) {
                const int dlo = 8 * fq;
                rope_tile(acc, row0, ropeB, 32, dlo, 32, [&](int row) { return kidx + (size_t)row * IDXD + dlo; });
            } else if (wc == 1 && fq < 2) {
#pragma unroll
                for (int ai = 0; ai < 2; ++ai)
#pragma unroll
                    for (int m = 0; m < 4; ++m) { const int row = row0 + ai * HALF + m * 16; float* dst = widx + (size_t)row * IDXH + 8 * fq;
                        *(f32x4*)dst = acc[ai][0][m][0]; *(f32x4*)(dst + 4) = acc[ai][0][m][1]; }
            }
        } else {
            f16* gp = pn < 37 ? ga : gb; const int ct = (pn < 37 ? pn - 29 : pn - 37) * BM + 32 * wc + 8 * fq;
#pragma unroll
            for (int ai = 0; ai < 2; ++ai)
#pragma unroll
                for (int m = 0; m < 4; ++m) { const int row = row0 + ai * HALF + m * 16;
#pragma unroll
                    for (int bj = 0; bj < 2; ++bj) { f32x4 a = acc[ai][bj][m][0], b = acc[ai][bj][m][1];
#pragma unroll
                        for (int e = 0; e < 4; ++e) { a[e] = sigmoidf_(a[e]); b[e] = sigmoidf_(b[e]); }
                        st8h(gp + (size_t)row * DM + ct + bj * HALF, a, b); } }
        }
    }
};
struct EpiOut {
    static constexpr bool PERM256 = true, KEEPS = true;
    const f16* ga; const f16* gb; unsigned char* y;
    __device__ __forceinline__ bool keep(const Unit& u) const { return u.z == 0; }
    __device__ __forceinline__ void operator()(AccT& acc, const Unit& u, int wr, int wc, int fr, int fq) const {
        const int row0 = u.pm * BM + wr * 64 + fr, col0 = u.pn * BM + 64 * wc + 16 * fq;
#pragma unroll
        for (int ai = 0; ai < 2; ++ai) {
            u32x4 wbv[4][2], wav[4][2];
#pragma unroll
            for (int m = 0; m < 4; ++m)
#pragma unroll
                for (int bj = 0; bj < 2; ++bj) { const size_t off = (size_t)(row0 + ai * HALF + m * 16) * DM + col0 + bj * 8;
                    wbv[m][bj] = *(const u32x4*)(gb + off); if (u.z == 0) wav[m][bj] = *(const u32x4*)(ga + off); }
#pragma unroll
            for (int m = 0; m < 4; ++m) { const size_t off = (size_t)(row0 + ai * HALF + m * 16) * DM + col0; u32x4 ow;
#pragma unroll
                for (int bj = 0; bj < 2; ++bj) {
                    const u32x4 wb = wbv[m][bj];
                    const f32x2 b0 = unpkh(wb.x), b1 = unpkh(wb.y), b2 = unpkh(wb.z), b3 = unpkh(wb.w);
                    if (u.z == 0) {
                        const u32x4 wa = wav[m][bj];
                        const f32x2 a0 = unpkh(wa.x), a1 = unpkh(wa.y), a2 = unpkh(wa.z), a3 = unpkh(wa.w);
                        f32x4& x = acc[ai][bj][m][0]; f32x4& w = acc[ai][bj][m][1];
                        x[0] *= a0.x * __builtin_amdgcn_rcpf(b0.x); x[1] *= a0.y * __builtin_amdgcn_rcpf(b0.y); x[2] *= a1.x * __builtin_amdgcn_rcpf(b1.x); x[3] *= a1.y * __builtin_amdgcn_rcpf(b1.y);
                        w[0] *= a2.x * __builtin_amdgcn_rcpf(b2.x); w[1] *= a2.y * __builtin_amdgcn_rcpf(b2.y); w[2] *= a3.x * __builtin_amdgcn_rcpf(b3.x); w[3] *= a3.y * __builtin_amdgcn_rcpf(b3.y);
                    } else {
                        f32x4 x = acc[ai][bj][m][0], w = acc[ai][bj][m][1];
                        x[0] *= b0.x; x[1] *= b0.y; x[2] *= b1.x; x[3] *= b1.y; w[0] *= b2.x; w[1] *= b2.y; w[2] *= b3.x; w[3] *= b3.y;
#pragma unroll
                        for (int e = 0; e < 4; ++e) { x[e] = __builtin_amdgcn_fmed3f(x[e] * 16.f, -448.f, 448.f); w[e] = __builtin_amdgcn_fmed3f(w[e] * 16.f, -448.f, 448.f); }
                        int w0 = 0, w1 = 0;
                        w0 = __builtin_amdgcn_cvt_pk_fp8_f32(x[0], x[1], w0, false); w0 = __builtin_amdgcn_cvt_pk_fp8_f32(x[2], x[3], w0, true);
                        w1 = __builtin_amdgcn_cvt_pk_fp8_f32(w[0], w[1], w1, false); w1 = __builtin_amdgcn_cvt_pk_fp8_f32(w[2], w[3], w1, true);
                        if (bj == 0) { ow.x = (unsigned)w0; ow.y = (unsigned)w1; } else { ow.z = (unsigned)w0; ow.w = (unsigned)w1; }
                    }
                }
                if (u.z != 0) *(u32x4*)(y + off) = ow; }
        }
    }
};
struct EpiSq {
    static constexpr bool PERM256 = false, KEEPS = false;
    f16* out; float* ssp;
    __device__ __forceinline__ bool keep(const Unit&) const { return false; }
    __device__ __forceinline__ void operator()(AccT& acc, const Unit& u, int wr, int wc, int fr, int fq) const {
        const int row0 = u.pm * BM + wr * 64 + fr, col0 = u.pn * BM + 32 * wc + 8 * fq;
#pragma unroll
        for (int ai = 0; ai < 2; ++ai)
#pragma unroll
            for (int m = 0; m < 4; ++m) { const int row = row0 + ai * HALF + m * 16; float s = 0.f;
#pragma unroll
                for (int bj = 0; bj < 2; ++bj) { const f32x4 a = acc[ai][bj][m][0], b = acc[ai][bj][m][1];
                    s += (a[0] * a[0] + a[1] * a[1]) + (a[2] * a[2] + a[3] * a[3]) + (b[0] * b[0] + b[1] * b[1]) + (b[2] * b[2] + b[3] * b[3]);
                    st8h(out + (size_t)row * DM + col0 + bj * HALF, a, b); }
                s += __shfl_xor(s, 16); s += __shfl_xor(s, 32);
                if (fq == 0) ssp[(size_t)row * 32 + u.pn * 4 + wc] = s; }
    }
};
struct EpiRelu2 {
    static constexpr bool PERM256 = true, KEEPS = false;
    unsigned char* out;
    __device__ __forceinline__ bool keep(const Unit&) const { return false; }
    __device__ __forceinline__ void operator()(AccT& acc, const Unit& u, int wr, int wc, int fr, int fq) const {
        const int row0 = u.pm * BM + wr * 64 + fr, col0 = u.pn * BM + 64 * wc + 16 * fq;
#pragma unroll
        for (int ai = 0; ai < 2; ++ai)
#pragma unroll
            for (int m = 0; m < 4; ++m) { const int row = row0 + ai * HALF + m * 16; u32x4 ow;
#pragma unroll
                for (int bj = 0; bj < 2; ++bj) { f32x4 a = acc[ai][bj][m][0], b = acc[ai][bj][m][1];
#pragma unroll
                    for (int e = 0; e < 4; ++e) { const float x = __builtin_amdgcn_fmed3f(a[e], 0.f, 21.16601f), y = __builtin_amdgcn_fmed3f(b[e], 0.f, 21.16601f); a[e] = x * x; b[e] = y * y; }
                    int w0 = 0, w1 = 0;
                    w0 = __builtin_amdgcn_cvt_pk_fp8_f32(a[0], a[1], w0, false); w0 = __builtin_amdgcn_cvt_pk_fp8_f32(a[2], a[3], w0, true);
                    w1 = __builtin_amdgcn_cvt_pk_fp8_f32(b[0], b[1], w1, false); w1 = __builtin_amdgcn_cvt_pk_fp8_f32(b[2], b[3], w1, true);
                    if (bj == 0) { ow.x = (unsigned)w0; ow.y = (unsigned)w1; } else { ow.z = (unsigned)w0; ow.w = (unsigned)w1; } }
                *(u32x4*)(out + (size_t)row * FF + col0) = ow; }
    }
};
}

namespace att {
constexpr int D = 128, NW = 8, QBLK = 32, KVBLK = 64, QB = NW * QBLK;
constexpr int SHM_V = KVBLK * D * 2, SHM_K = KVBLK * D * 2;
constexpr int LDS_SELM = 2 * SHM_V + 2 * SHM_K + NW * 64 * 4;
constexpr int LDS_KM = LDS_SELM + 2 * 256 * 4;
constexpr int LDS_Q = 79872;
constexpr float SCALE = 0.08838834764831845f, THR = 8.f;
#define KSWZ(row, colB) ((row) * 256 + ((colB) ^ (((row) & 7) << 4)))
#define SBAR() __builtin_amdgcn_sched_barrier(0)
__device__ __forceinline__ int v_st(int k, int c) { const int kk = (k & ~0xC) | ((k & 4) << 1) | ((k & 8) >> 1); return ((kk >> 3) * 4 + (c >> 5)) * 512 + ((kk & 7) * 32 + (c & 31)) * 2; }
__device__ __forceinline__ int v_rd_base(int lane) { return ((lane & 3) << 3) | (((lane >> 2) & 3) << 6) | (((lane >> 4) & 1) << 5) | (((lane >> 5) & 1) << 8); }
constexpr int v_rd_off(int d0, int ks, int half) { return d0 * 512 + ks * 4096 + half * 2048; }
__device__ __forceinline__ int crow(int r, int hi) { return (r & 3) + 8 * (r >> 2) + 4 * hi; }
__device__ __forceinline__ f16x8 load8(const f16* p) { return *reinterpret_cast<const f16x8*>(p); }
__device__ __forceinline__ void mask_causal(f32x16& p0, f32x16& p1, int dq) {
    const float NEG = -__builtin_inff();
#pragma unroll
    for (int r = 0; r < 16; ++r) { const int c = (r & 3) + 8 * (r >> 2); if (dq - c < 0) p0[r] = NEG; if (dq - c - 32 < 0) p1[r] = NEG; }
}
__device__ __forceinline__ void mask_bits(f32x16& p0, f32x16& p1, unsigned w0, unsigned w1) {
#pragma unroll
    for (int r = 0; r < 16; ++r) { const int c = (r & 3) + 8 * (r >> 2);
        const unsigned m0 = (unsigned)__builtin_amdgcn_sbfe((int)w0, c, 1), m1 = (unsigned)__builtin_amdgcn_sbfe((int)w1, c, 1);
        p0[r] = __uint_as_float((__float_as_uint(p0[r]) & m0) | (~m0 & 0xFF800000u));
        p1[r] = __uint_as_float((__float_as_uint(p1[r]) & m1) | (~m1 & 0xFF800000u)); }
}
__device__ __forceinline__ float sm_max(const f32x16& p0, const f32x16& p1) {
    float pmax, pmb;
    asm("v_max3_f32 %0, %1, %2, %3" : "=v"(pmax) : "v"(p0[0]), "v"(p0[1]), "v"(p0[2])); asm("v_max3_f32 %0, %1, %2, %3" : "=v"(pmb) : "v"(p1[0]), "v"(p1[1]), "v"(p1[2]));
#pragma unroll
    for (int r = 3; r < 15; r += 2) { asm("v_max3_f32 %0, %0, %1, %2" : "+v"(pmax) : "v"(p0[r]), "v"(p0[r + 1])); asm("v_max3_f32 %0, %0, %1, %2" : "+v"(pmb) : "v"(p1[r]), "v"(p1[r + 1])); }
    asm("v_max3_f32 %0, %0, %1, %2" : "+v"(pmax) : "v"(p0[15]), "v"(p1[15])); asm("v_max_f32 %0, %0, %1" : "+v"(pmax) : "v"(pmb));
    { auto rr = __builtin_amdgcn_permlane32_swap(__float_as_uint(pmax), __float_as_uint(pmax), false, false);
      float a_ = __uint_as_float(rr[0]), b_ = __uint_as_float(rr[1]); asm("v_max_f32 %0, %1, %2" : "=v"(pmax) : "v"(a_), "v"(b_)); }
    return pmax;
}
__device__ __forceinline__ float sm_decide(float pmax, float& m_reg, float& mn, float& alpha) {
    constexpr float C2 = 1.4426950408889634f * SCALE;
    if (__builtin_expect(__all((pmax - m_reg) * SCALE <= THR), 1)) { mn = m_reg; alpha = 1.f; }
    else { mn = fmaxf(m_reg, pmax); alpha = __builtin_amdgcn_exp2f((m_reg - mn) * C2); m_reg = mn; }
    return -mn * C2;
}
__device__ __forceinline__ void sm_fma(f32x16& p, float mnL) { constexpr float C2 = 1.4426950408889634f * SCALE; for (int r = 0; r < 16; ++r) p[r] = fmaf(p[r], C2, mnL); }
__device__ __forceinline__ void sm_exp(f32x16& p) { for (int r = 0; r < 16; ++r) p[r] = __builtin_amdgcn_exp2f(p[r]); }
__device__ __forceinline__ void partialSM(f32x16& p0, f32x16& p1, float& m_reg, float& mn, float& alpha, bool ok = true) {
    float pmax = sm_max(p0, p1); pmax = ok ? pmax : -1e30f; float mnL = sm_decide(pmax, m_reg, mn, alpha); mnL = ok ? mnL : -__builtin_inff(); sm_fma(p0, mnL); sm_fma(p1, mnL); sm_exp(p0);
}
__device__ __forceinline__ void finishSM(f32x16& p0, f32x16& p1, float alpha, float& l_reg, f16x8& pa0, f16x8& pa1, f16x8& pa2, f16x8& pa3) {
    for (int r = 0; r < 16; ++r) p1[r] = __builtin_amdgcn_exp2f(p1[r]);
    float ps = 0; for (int r = 0; r < 16; ++r) ps += p0[r]; for (int r = 0; r < 16; ++r) ps += p1[r];
    { auto rr = __builtin_amdgcn_permlane32_swap(__float_as_uint(ps), __float_as_uint(ps), false, false);
      ps = __uint_as_float(rr[0]) + __uint_as_float(rr[1]); }
    l_reg = l_reg * alpha + ps;
#define PK4(P, B_, OUT) do { unsigned a0 = pkh(P[B_+0], P[B_+1]), a1 = pkh(P[B_+2], P[B_+3]);                          \
        unsigned b0 = pkh(P[B_+4], P[B_+5]), b1 = pkh(P[B_+6], P[B_+7]);                                             \
        auto r0 = __builtin_amdgcn_permlane32_swap(a0, b0, false, false); auto r1 = __builtin_amdgcn_permlane32_swap(a1, b1, false, false); \
        u32x4 w = {r0[0], r1[0], r0[1], r1[1]}; OUT = *reinterpret_cast<f16x8*>(&w); } while (0)
    PK4(p0, 0, pa0); PK4(p0, 8, pa1); PK4(p1, 0, pa2); PK4(p1, 8, pa3);
#undef PK4
}
#define ATT_TRRD(dst, off) asm volatile("ds_read_b64_tr_b16 %0, %1 offset:%2" : "=&v"(dst) : "v"(vb0), "i"(off) : "memory")
#define ATT_MKV(l, h) __builtin_bit_cast(f16x8, (__attribute__((ext_vector_type(8))) short){l[0], l[1], l[2], l[3], h[0], h[1], h[2], h[3]})
#define ATT_PVG(VB, d0) do { s16x4 l0, l1, l2, l3, h0, h1, h2, h3; constexpr int b_ = (VB) * SHM_V + v_rd_off(d0, 0, 0); \
        ATT_TRRD(l0, b_); ATT_TRRD(h0, b_ + 2048); ATT_TRRD(l1, b_ + 4096); ATT_TRRD(h1, b_ + 6144); ATT_TRRD(l2, b_ + 8192); ATT_TRRD(h2, b_ + 10240); ATT_TRRD(l3, b_ + 12288); ATT_TRRD(h3, b_ + 14336); \
        asm volatile("s_waitcnt lgkmcnt(0)" ::: "memory"); SBAR();   \
        o[d0] = __builtin_amdgcn_mfma_f32_32x32x16_f16(pa0, ATT_MKV(l0, h0), o[d0], 0, 0, 0);   \
        o[d0] = __builtin_amdgcn_mfma_f32_32x32x16_f16(pa1, ATT_MKV(l1, h1), o[d0], 0, 0, 0);   \
        o[d0] = __builtin_amdgcn_mfma_f32_32x32x16_f16(pa2, ATT_MKV(l2, h2), o[d0], 0, 0, 0);   \
        o[d0] = __builtin_amdgcn_mfma_f32_32x32x16_f16(pa3, ATT_MKV(l3, h3), o[d0], 0, 0, 0); SBAR(); } while (0)
template <int VB>
__device__ __forceinline__ void pv_tile(f32x16* o, int vb0, f16x8 pa0, f16x8 pa1, f16x8 pa2, f16x8 pa3) {
#define TRRD(dst, off) asm volatile("ds_read_b64_tr_b16 %0, %1 offset:%2" : "=&v"(dst) : "v"(vb0), "i"(off) : "memory")
#define MKV(l, h) __builtin_bit_cast(f16x8, (__attribute__((ext_vector_type(8))) short){l[0], l[1], l[2], l[3], h[0], h[1], h[2], h[3]})
#define PV_D0(d0) do { s16x4 l0, l1, l2, l3, h0, h1, h2, h3; constexpr int b_ = VB * SHM_V + v_rd_off(d0, 0, 0); \
        TRRD(l0, b_); TRRD(h0, b_ + 2048); TRRD(l1, b_ + 4096); TRRD(h1, b_ + 6144); TRRD(l2, b_ + 8192); TRRD(h2, b_ + 10240); TRRD(l3, b_ + 12288); TRRD(h3, b_ + 14336); \
        asm volatile("s_waitcnt lgkmcnt(0)" ::: "memory"); SBAR();   \
        o[d0] = __builtin_amdgcn_mfma_f32_32x32x16_f16(pa0, MKV(l0, h0), o[d0], 0, 0, 0);   \
        o[d0] = __builtin_amdgcn_mfma_f32_32x32x16_f16(pa1, MKV(l1, h1), o[d0], 0, 0, 0);   \
        o[d0] = __builtin_amdgcn_mfma_f32_32x32x16_f16(pa2, MKV(l2, h2), o[d0], 0, 0, 0);   \
        o[d0] = __builtin_amdgcn_mfma_f32_32x32x16_f16(pa3, MKV(l3, h3), o[d0], 0, 0, 0); } while (0)
    PV_D0(0); PV_D0(1); PV_D0(2); PV_D0(3);
#undef PV_D0
#undef MKV
#undef TRRD
}
struct BlockRef { const f16* Q; const f16* K; const f16* V; f16* O; int P0; const u64* M; const unsigned* sel; };
#define ROW(p, k0, rr) ((p) + (size_t)((k0) + (rr)) * D + sc)
#define VMW() asm volatile("s_waitcnt vmcnt(0)" ::: "memory")
#define SLOAD_H(Kp, Vp, k0) do { st_v0 = load8(ROW(Vp, k0, sr)); st_v1 = load8(ROW(Vp, k0, 32 + sr));              \
                         st_k0 = load8(ROW(Kp, k0, sr)); st_k1 = load8(ROW(Kp, k0, 32 + sr)); } while (0)
#define SWRITE_HK(bf) do { *(f16x8*)(K_lds + (bf) * SHM_K + kws) = st_k0; *(f16x8*)(K_lds + (bf) * SHM_K + kws + 32 * 256) = st_k1; } while (0)
#define SWRITE_HV(bf) do { *(f16x8*)(V_lds + (bf) * SHM_V + vst0) = st_v0; *(f16x8*)(V_lds + (bf) * SHM_V + vst1) = st_v1; } while (0)
#define SWRITE_H(bf) do { SWRITE_HV(bf); SWRITE_HK(bf); } while (0)
template <int KB, bool QREG>
__device__ __forceinline__ void qkt(f32x16& p0, f32x16& p1, const char* K_lds, const char* Qw_lds, int r32, int hi, const f16x8* qr) {
    p0 = f32x16{}; p1 = f32x16{};
    int ko[4];
#pragma unroll
    for (int dd = 0; dd < 4; ++dd) ko[dd] = KSWZ(r32, (dd * 16 + hi * 8) * 2);
#pragma unroll
    for (int d0 = 0; d0 < 8; ++d0) { const char* a = K_lds + KB * SHM_K + ko[d0 & 3] + (d0 >> 2) * 128;
        f16x8 b0 = *reinterpret_cast<const f16x8*>(a);
        f16x8 b1 = *reinterpret_cast<const f16x8*>(a + 32 * 256);
        f16x8 qf = QREG ? qr[d0] : *reinterpret_cast<const f16x8*>(Qw_lds + ko[d0 & 3] + (d0 >> 2) * 128);
        p0 = __builtin_amdgcn_mfma_f32_32x32x16_f16(b0, qf, p0, 0, 0, 0);
        p1 = __builtin_amdgcn_mfma_f32_32x32x16_f16(b1, qf, p1, 0, 0, 0); }
}
template <int KIND, bool QREG>
__device__ __forceinline__ void attn_block(const BlockRef& cur, char* lds) {
    const int tid = threadIdx.x, wid = __builtin_amdgcn_readfirstlane(tid >> 6), lane = tid & 63, r32 = lane & 31, hi = lane >> 5;
    const int NT = (cur.P0 + QB) / KVBLK;
    const int qlo = cur.P0 + wid * QBLK, qm = qlo + r32 - 4 * hi;
    char* V_lds = lds; char* K_lds = lds + 2 * SHM_V; char* Qw_lds = lds + LDS_Q + wid * 8192;
    float* ws = (float*)(lds + 2 * SHM_V + 2 * SHM_K) + wid * 64; float* li_l = ws, * al_l = ws + 32;
    float m_reg = -1e30f, l_reg = 0; f32x16 o[4] = {};
    const int sr = tid >> 4, sc = (tid & 15) * 8, vst0 = v_st(sr, sc), vst1 = v_st(32 + sr, sc), kws = KSWZ(sr, sc * 2);
    const int vb0 = (int)(uintptr_t)V_lds + v_rd_base(lane);
    const f16* Kh = cur.K; const f16* Vh = cur.V;
    f16x8 st_v0, st_v1, st_k0, st_k1; f16x8 qr[8];
    unsigned selw = 0; const int moff = (wid * QBLK + r32) * 64; u64 mcur = 0;
    if constexpr (KIND == 0) { selw = cur.sel[wid * QBLK + r32]; }
#define MLOAD(t) do { if constexpr (KIND == 1) mcur = cur.M[moff + (t)]; } while (0)
#define RESC(a) do { if (__any((a) < 1.f)) { if (hi == 0) al_l[r32] = (a); asm volatile("s_waitcnt lgkmcnt(0)" ::: "memory");              \
                     for (int d_ = 0; d_ < 4; ++d_) for (int r = 0; r < 16; ++r) o[d_][r] *= al_l[crow(r, hi)]; } } while (0)
#define KBASE(t) ((t) * KVBLK)
#define MASKT(P0_, P1_, t) do { const int kb_ = KBASE(t);                                                                                   \
        if constexpr (KIND == 0) { if (kb_ >= cur.P0) { if (kb_ + KVBLK - 1 > qlo) mask_causal(P0_, P1_, qm - kb_); } }                     \
        else { mask_bits(P0_, P1_, (unsigned)mcur >> (4 * hi), (unsigned)(mcur >> 32) >> (4 * hi)); } } while (0)
#define ROWOK(t) ((KIND != 0) || (KBASE(t) >= cur.P0) || (((selw >> (KBASE(t) >> 8)) & 1u) != 0u))
    f32x16 pA0, pA1, pB0, pB1; float mnA, mnB, alA, alB; f16x8 pa0, pa1, pa2, pa3;
    {
#pragma unroll
        for (int d0 = 0; d0 < 8; ++d0) { const f16x8 qv = load8(cur.Q + (size_t)(wid * QBLK + r32) * D + d0 * 16 + hi * 8);
            if (QREG) qr[d0] = qv; else *(f16x8*)(Qw_lds + KSWZ(r32, (d0 * 16 + hi * 8) * 2)) = qv; }
        SLOAD_H(Kh, Vh, 0); VMW(); SWRITE_H(0);
    }
    __syncthreads();
    if (NT > 1) { SLOAD_H(Kh, Vh, KBASE(1)); }
    MLOAD(0); SBAR(); qkt<0, QREG>(pA0, pA1, K_lds, Qw_lds, r32, hi, qr); asm volatile("s_nop 15\n\ts_nop 7" : "+v"(pA0), "+v"(pA1));
    MASKT(pA0, pA1, 0); partialSM(pA0, pA1, m_reg, mnA, alA, ROWOK(0));
    if (NT > 1) { VMW(); SWRITE_H(1); }
    __syncthreads();
#define HALF_STEP(PX0, PX1, mnX, alX, PY0, PY1, alY, t, KB, VB, SB) do {                                                      \
        MLOAD(t); SBAR(); qkt<KB, QREG>(PX0, PX1, K_lds, Qw_lds, r32, hi, qr);                                                          \
        finishSM(PY0, PY1, alY, l_reg, pa0, pa1, pa2, pa3); SBAR();                                                           \
        if ((t) + 1 < NT) { SLOAD_H(Kh, Vh, KBASE((t) + 1)); SBAR(); }                                                        \
          \
        ATT_PVG(VB, 0); MASKT(PX0, PX1, (t)); float pmx_ = sm_max(PX0, PX1); if constexpr (KIND == 0) pmx_ = ROWOK(t) ? pmx_ : -1e30f; SBAR(); \
        ATT_PVG(VB, 1); float mnl_ = sm_decide(pmx_, m_reg, mnX, alX); if constexpr (KIND == 0) mnl_ = ROWOK(t) ? mnl_ : -__builtin_inff(); sm_fma(PX0, mnl_); SBAR(); \
        ATT_PVG(VB, 2); sm_fma(PX1, mnl_); SBAR();                                                                            \
        ATT_PVG(VB, 3); sm_exp(PX0);                                                                                          \
        __syncthreads();                                                                                                      \
        if ((t) + 1 < NT) { VMW(); SWRITE_H(SB); }                                                                            \
        RESC(alX); __syncthreads(); } while (0)
    for (int t = 1; t + 1 < NT; t += 2) {
        HALF_STEP(pB0, pB1, mnB, alB, pA0, pA1, alA, t, 1, 0, 0);
        HALF_STEP(pA0, pA1, mnA, alA, pB0, pB1, alB, t + 1, 0, 1, 1);
    }
    MLOAD(NT - 1); SBAR(); qkt<1, QREG>(pB0, pB1, K_lds, Qw_lds, r32, hi, qr); SBAR();
    finishSM(pA0, pA1, alA, l_reg, pa0, pa1, pa2, pa3); SBAR();
    pv_tile<0>(o, vb0, pa0, pa1, pa2, pa3);
    MASKT(pB0, pB1, NT - 1); partialSM(pB0, pB1, m_reg, mnB, alB); RESC(alB);
    finishSM(pB0, pB1, alB, l_reg, pa0, pa1, pa2, pa3); SBAR(); pv_tile<1>(o, vb0, pa0, pa1, pa2, pa3);
    if (hi == 0) li_l[r32] = l_reg; asm volatile("s_waitcnt lgkmcnt(0)" ::: "memory");
    float rli[16];
#pragma unroll
    for (int r = 0; r < 16; ++r) rli[r] = __builtin_amdgcn_rcpf(li_l[crow(r, hi)]);
    int le = lane; asm volatile("" : "+v"(le));
    f16* Ow = cur.O + (size_t)(wid * QBLK) * AW; f16* stg = (f16*)(lds + LDS_Q) + wid * 4096; f16* sw = stg + (4 * (le >> 5)) * 128 + (le & 31);
#pragma unroll
    for (int r = 0; r < 16; ++r) { const int ob = ((r & 3) + 8 * (r >> 2)) * 128;
#pragma unroll
        for (int d0 = 0; d0 < 4; ++d0) sw[ob + d0 * 32] = (f16)(o[d0][r] * rli[r]); }
    asm volatile("s_waitcnt lgkmcnt(0)" ::: "memory");
    const f16* sr_ = stg + (le >> 4) * 128 + (le & 15) * 8; f16* og = Ow + (size_t)(le >> 4) * AW + (le & 15) * 8;
#pragma unroll
    for (int i = 0; i < 8; ++i) { const u32x4 v = *(const u32x4*)(sr_ + i * 4 * 128); *(u32x4*)(og + (size_t)i * 4 * AW) = v; }
    __syncthreads();
#undef RESC
#undef KBASE
#undef MASKT
#undef ROWOK
#undef MLOAD
#undef HALF_STEP
}
#undef ROW
#undef VMW
#undef SLOAD_H
#undef SWRITE_HK
#undef SWRITE_HV
#undef SWRITE_H
#undef SBAR
}

constexpr int NWAVES = 8;
constexpr int RING_BYTES = 131072;
constexpr int LDSCTL_OFF = 146432, MISC_OFF = LDSCTL_OFF + 320;
constexpr int LDS_BYTES = 147456;
constexpr int CW_TMO = 0, CW_QUEUE = 64, CW_QUEUE2 = 128, CW_BAR = 4096;
typedef GAS unsigned gu32;
#define RLX_AGENT __ATOMIC_RELAXED, __HIP_MEMORY_SCOPE_AGENT

#define XB_TMO      128
#define XB_XCNT(j)  (256  + 64 * (j))
#define XB_XSUB(j)  (1280 + 64 * (j))
#define XB_XGEN(j)  (2304 + 64 * (j))
#define XB_TOP      3328
#define XB_TOPGEN   3392
#define XCD_BAR_WORDS 3456
#define XB_SPIN_CAP (1u << 20)
__device__ __forceinline__ unsigned xb_ld(unsigned* p)              { return __hip_atomic_load(p, __ATOMIC_RELAXED, __HIP_MEMORY_SCOPE_AGENT); }
__device__ __forceinline__ unsigned xb_add(unsigned* p, unsigned v) { return __hip_atomic_fetch_add(p, v, __ATOMIC_RELAXED, __HIP_MEMORY_SCOPE_AGENT); }
__device__ __forceinline__ unsigned xb_xcc_id() { return (unsigned)__builtin_amdgcn_s_getreg((3 << 11) | 20) & 0xFu; }
#define XB_SPIN(cond, bar) do { unsigned _sp = 0; while (cond) { __builtin_amdgcn_s_sleep(1); \
    if ((++_sp & 255u) == 0u) { if (xb_ld(&(bar)[XB_TMO])) break; if (_sp > XB_SPIN_CAP) { atomicAdd(&(bar)[XB_TMO], 1u); break; } } } } while (0)
struct XcdBarrier { unsigned* bar; unsigned x; volatile LAS unsigned* st; };
__device__ __forceinline__ XcdBarrier xcd_barrier_post(unsigned* bar, volatile LAS unsigned* st) {
    XcdBarrier b; b.bar = bar; b.x = xb_xcc_id(); b.st = st;
    if (threadIdx.x == 0) (void)xb_add(&bar[XB_XCNT(b.x)], 1u);
    return b;
}
__device__ __forceinline__ void xcd_barrier_complete(unsigned* bar, unsigned x, unsigned& nloc, unsigned& nx) {
    const unsigned G = gridDim.x * gridDim.y * gridDim.z;
    unsigned sum, cnt, mine, sp = 0u;
    for (;;) {
        sum = 0u; cnt = 0u; mine = 0u;
#pragma unroll
        for (unsigned j = 0; j < 16; ++j) { const unsigned c = xb_ld(&bar[XB_XCNT(j)]); sum += c; cnt += (c > 0u) ? 1u : 0u; mine = (j == x) ? c : mine; }
        if (sum == G) break;
        __builtin_amdgcn_s_sleep(1);
        if ((++sp & 255u) == 0u) { if (xb_ld(&bar[XB_TMO])) break; if (sp > XB_SPIN_CAP) { atomicAdd(&bar[XB_TMO], 1u); break; } }
    }
    nloc = mine > 0u ? mine : 1u; nx = cnt > 0u ? cnt : 1u;
}
__device__ __forceinline__ void xcd_barrier(const XcdBarrier& b) {
    asm volatile("s_waitcnt vmcnt(0)" ::: "memory");
    __syncthreads();
    if (threadIdx.x == 0) {
        unsigned* bar = b.bar;
        __builtin_amdgcn_s_waitcnt(0);
        unsigned nloc = b.st[0], nx = b.st[1];
        if (nloc == 0u) { xcd_barrier_complete(bar, b.x, nloc, nx); b.st[0] = nloc; b.st[1] = nx; }
        const unsigned old = xb_add(&bar[XB_XSUB(b.x)], 1u);
        const unsigned gen = old / nloc;
        if (old + 1u == (gen + 1u) * nloc) {
            __builtin_amdgcn_fence(__ATOMIC_RELEASE, "agent");
            asm volatile("s_waitcnt vmcnt(0)" ::: "memory");
            const unsigned og = xb_add(&bar[XB_TOP], 1u);
            const unsigned tg = og / nx;
            if (og + 1u == (tg + 1u) * nx) xb_add(&bar[XB_TOPGEN], 1u);
            else XB_SPIN(xb_ld(&bar[XB_TOPGEN]) == tg, bar);
            __builtin_amdgcn_fence(__ATOMIC_ACQUIRE, "agent");
            xb_add(&bar[XB_XGEN(b.x)], 1u);
            asm volatile("s_waitcnt vmcnt(0)" ::: "memory");
        } else {
            XB_SPIN(xb_ld(&bar[XB_XGEN(b.x)]) == gen, bar);
            __builtin_amdgcn_fence(__ATOMIC_ACQUIRE, "agent");
            asm volatile("s_waitcnt vmcnt(0)" ::: "memory");
        }
    }
    __syncthreads();
}

struct Args { const float* in[14]; float* out; unsigned char* ws; int ph_lo, ph_hi; };
constexpr int PTRTAB_OFF = LDSCTL_OFF + 512;
__device__ __forceinline__ const float* ldptr(LAS unsigned char* lds, int i) {
    const LAS unsigned* p = (const LAS unsigned*)(lds + PTRTAB_OFF) + 2 * i; asm volatile("" ::: "memory");
    const unsigned lo = __builtin_amdgcn_readfirstlane(p[0]), hi = __builtin_amdgcn_readfirstlane(p[1]);
    return (const float*)(((u64)hi << 32) | lo);
}

__device__ __forceinline__ void conv_load(f32x4 (&r)[16], const float* src0, const float* src1, int N, int lane) {
    const float* sp = (lane & 8) ? src1 : src0;
    if (sp) {
#pragma unroll
        for (int i = 0; i < 16; ++i) r[i] = __builtin_nontemporal_load((const f32x4*)(sp + (size_t)(4 * i + (lane >> 4)) * N + 4 * (lane & 7)));
    } else {
#pragma unroll
        for (int i = 0; i < 16; ++i) r[i] = (f32x4){0.f, 0.f, 0.f, 0.f};
    }
}
__device__ __forceinline__ void conv_store(const f32x4 (&r)[16], f16* dst, int K, LAS float* scr, int lane) {
#pragma unroll
    for (int i = 0; i < 16; ++i) { LAS float* wp = scr + (4 * i + (lane >> 4)) * 65 + 4 * (lane & 15); wp[0] = r[i][0]; wp[1] = r[i][1]; wp[2] = r[i][2]; wp[3] = r[i][3]; }
    LDS_WAIT(); asm volatile("" ::: "memory");
    const int c = lane & 7;
#pragma unroll
    for (int j = 0; j < 8; ++j) { const int n = (lane >> 3) + 8 * j; const LAS float* sp = scr + (8 * c) * 65 + n;
        if (K < 0) { int w0 = 0, w1 = 0;
            w0 = __builtin_amdgcn_cvt_pk_fp8_f32(sp[0 * 65] * 256.f, sp[1 * 65] * 256.f, w0, false); w0 = __builtin_amdgcn_cvt_pk_fp8_f32(sp[2 * 65] * 256.f, sp[3 * 65] * 256.f, w0, true);
            w1 = __builtin_amdgcn_cvt_pk_fp8_f32(sp[4 * 65] * 256.f, sp[5 * 65] * 256.f, w1, false); w1 = __builtin_amdgcn_cvt_pk_fp8_f32(sp[6 * 65] * 256.f, sp[7 * 65] * 256.f, w1, true);
            *(GAS u32x2*)((unsigned char*)dst + (size_t)n * (size_t)(-K) + 8 * c) = (u32x2){(unsigned)w0, (unsigned)w1}; continue; }
        u32x4 o; o.x = pkh(sp[0 * 65], sp[1 * 65]); o.y = pkh(sp[2 * 65], sp[3 * 65]); o.z = pkh(sp[4 * 65], sp[5 * 65]); o.w = pkh(sp[6 * 65], sp[7 * 65]);
        *(GAS u32x4*)(dst + (size_t)n * K + 8 * c) = o; }
    LDS_WAIT(); asm volatile("" ::: "memory");
}
template <class Dec>
__device__ __forceinline__ void conv_stream(int first, int total, int stride, const Dec& dec, LAS float* scr, int lane) {
    int it = first; if (it >= total) return;
    f32x4 ra[16], rb[16];
    const float* a0; const float* a1; f16* ad; int aK, aN; const float* b0; const float* b1; f16* bd; int bK, bN;
    dec(it, a0, a1, ad, aK, aN); b0 = a0; b1 = a1; bd = ad; bK = aK; bN = aN; conv_load(ra, a0, a1, aN, lane);
    for (;;) {
        bool more = it + stride < total; if (more) { dec(it + stride, b0, b1, bd, bK, bN); conv_load(rb, b0, b1, bN, lane); }
        conv_store(ra, ad, aK, scr, lane); if (!more) break; it += stride;
        more = it + stride < total; if (more) { dec(it + stride, a0, a1, ad, aK, aN); conv_load(ra, a0, a1, aN, lane); }
        conv_store(rb, bd, bK, scr, lane); if (!more) break; it += stride;
    }
}
__device__ __forceinline__ int win_src_col(int rb) {
    const int pn = rb >> 3, jb = rb & 7, bj = jb >> 2, qq = jb & 3;
    if (pn < 24) { const int kind6 = pn >> 2, hp = pn & 3, base = kind6 * AW;
        if ((kind6 % 3) != 2) return base + (2 * hp + (qq >> 1)) * HD + 32 * (qq & 1) + 64 * bj;
        return base + hp * 256 + 32 * jb; }
    if (pn < 28) return C_QI + (4 * (pn - 24) + qq) * IDXD + 32 * bj;
    if (pn == 28) { if (jb == 0) return C_KI; if (jb == 4) return C_KI + 32; if (jb == 1) return C_WI; return -1; }
    if (pn < 37) return C_GA + (pn - 29) * 256 + 32 * jb;
    return C_GB + (pn - 37) * 256 + 32 * jb;
}
constexpr int CONV_I_IN = (DM / 64) * (N_IN_PAD / 64), CONV_I_MO = (AW / 64) * (DM / 64), CONV_I_O = (DM / 64) * (DM / 64), CONV_I_1 = (DM / 64) * (FF / 64), CONV_I_2 = (FF / 64) * (DM / 64);
constexpr int CONV_TOTAL = CONV_I_IN + 2 * CONV_I_MO + CONV_I_O + CONV_I_1 + CONV_I_2;
constexpr int CONV_SPLIT = CONV_I_IN + 2 * CONV_I_MO + CONV_I_O;
__device__ __forceinline__ void conv_items(unsigned char* ws, const float* win, const float* wmo, const float* wdo, const float* wo, const float* w1, const float* w2,
                                           LAS unsigned char* lds, int lo, int hi, int first, int stride, int wave, int lane) {
    constexpr int I_IN = CONV_I_IN, I_MO = CONV_I_MO, I_O = CONV_I_O, I_1 = CONV_I_1;
    LAS float* scr64 = (LAS float*)(lds + wave * 16640);
    conv_stream(lo + first, hi, stride, [&](int r, const float*& s0, const float*& s1, f16*& dst, int& K, int& N) {
            if (r < I_IN) { const int nb = N_IN_PAD / 64, kb = r / nb, rbd = r % nb; const float* base = win + (size_t)kb * 64 * D_IN; N = D_IN;
                const bool f8 = rbd >= 84; const int q = f8 ? rbd - 84 : rbd, p_ = q >> 2, pt = f8 ? (p_ < 4 ? 8 + p_ : (p_ < 8 ? 16 + p_ : 21 + p_)) : (p_ < 8 ? p_ : (p_ < 16 ? p_ + 4 : p_ + 8));
                const int rb = pt * 4 + (q & 3), c0 = win_src_col(2 * rb), c1 = win_src_col(2 * rb + 1);
                s0 = c0 >= 0 ? base + c0 : nullptr; s1 = c1 >= 0 ? base + c1 : nullptr;
                if (f8) { dst = (f16*)((unsigned char*)(ws + WS_WG8) + (size_t)q * 64 * DM + kb * 64); K = -DM; } else { dst = (f16*)(ws + WS_WIN) + (size_t)q * 64 * DM + kb * 64; K = DM; }
                return; }
            r -= I_IN; const float* W; f16* WT;
            if (r < I_MO) { W = wmo; WT = (f16*)(ws + WS_WMO); K = AW; N = DM; }
            else if ((r -= I_MO) < I_MO) { W = wdo; WT = (f16*)(ws + WS_WDO); K = AW; N = DM; }
            else if ((r -= I_MO) < I_O) { const int nb = DM / 64, kb = r / nb, rb = r % nb;
                s0 = wo + (size_t)kb * 64 * DM + rb * 64; s1 = s0 + 32; dst = (f16*)((unsigned char*)(ws + WS_WO) + (size_t)rb * 64 * DM + kb * 64); K = -DM; N = DM; return; }
            else if ((r -= I_O) < I_1) { W = w1; WT = (f16*)(ws + WS_W1); K = DM; N = FF; }
            else { r -= I_1; const int nb = DM / 64, kb = r / nb, rb = r % nb;
                s0 = w2 + (size_t)kb * 64 * DM + rb * 64; s1 = s0 + 32; dst = (f16*)((unsigned char*)(ws + WS_W2) + (size_t)rb * 64 * FF + kb * 64); K = -FF; N = DM; return; }
            const int nb = N / 64, kb = r / nb, rb = r % nb;
            s0 = W + (size_t)kb * 64 * N + rb * 64; s1 = s0 + 32; dst = WT + (size_t)rb * 64 * K + kb * 64; }, scr64, lane);
}
__device__ __forceinline__ void p0_prologue(const Args& a, LAS unsigned char* lds, int vcu, int G, int wave, int lane, int tid) {
    unsigned char* ws = a.ws;
    LAS float* scr = (LAS float*)(lds + wave * 16384);
    const int gw = vcu * NWAVES + wave, NGW = G * NWAVES;
    {
        const float* c = a.in[1]; const float* wada = a.in[2]; float* modp = (float*)(ws + WS_MODP);
        for (int it = gw; it < 64 * 32; it += NGW) {
            const int cc = it & 63, kc = it >> 6, k0 = kc * 64;
            if (lane < 48) {
                f32x4 a0 = {0.f, 0.f, 0.f, 0.f}, a1 = {0.f, 0.f, 0.f, 0.f};
                const float* wp = wada + (size_t)k0 * (6 * DM) + cc * 192 + lane * 4;
#pragma unroll 16
                for (int kk = 0; kk < 64; ++kk) {
                    const f32x4 wv = __builtin_nontemporal_load((const f32x4*)(wp + (size_t)kk * (6 * DM)));
                    const float c0 = c[k0 + kk], c1 = c[DM + k0 + kk];
                    const float s0 = c0 * sigmoidf_(c0), s1 = c1 * sigmoidf_(c1);
                    a0 += wv * s0; a1 += wv * s1;
                }
                *(f32x4*)(modp + (size_t)(kc * 2 + 0) * (6 * DM) + cc * 192 + lane * 4) = a0;
                *(f32x4*)(modp + (size_t)(kc * 2 + 1) * (6 * DM) + cc * 192 + lane * 4) = a1;
            }
        }
    }
    conv_items(ws, a.in[6], a.in[7], a.in[8], a.in[9], a.in[12], a.in[13], lds, 0, CONV_SPLIT, gw, NGW, wave, lane);
    {
        float* ra = (float*)(ws + WS_ROPEA); float* rb = (float*)(ws + WS_ROPEB);
        const int gt = vcu * (NWAVES * 64) + tid, NGT = G * NWAVES * 64;
        for (int i = gt; i < SEQ * 64 + SEQ * 32; i += NGT) {
            int t, f, half; float* dst;
            if (i < SEQ * 64) { t = i >> 6; f = i & 63; half = 64; dst = ra + (size_t)(i >> 2) * 8 + (i & 3); } else { const int j = i - SEQ * 64; t = j >> 5; f = j & 31; half = 32; dst = rb + (size_t)(j >> 2) * 8 + (j & 3); }
            const float inv = (float)exp2(-(double)f / (double)half * 13.287712379549449);
            const float ang = (float)t * inv;
            double sn, cs; sn = sin((double)ang); cs = cos((double)ang);
            dst[0] = (float)cs; dst[4] = (float)sn;
        }
    }
}

__device__ __forceinline__ f32x4 mod4(const float* modp, const float* bada, int b, int j) {
    f32x4 s = *(const f32x4*)(bada + j);
#pragma unroll
    for (int kc = 0; kc < 32; ++kc) s += *(const f32x4*)(modp + (size_t)(kc * 2 + b) * (6 * DM) + j);
    return s;
}
__device__ __forceinline__ void p1_norm_in(const Args& a, LAS unsigned char* lds, int vcu, int G, int wave, int lane, int tid) {
    unsigned char* ws = a.ws; const float* x = a.in[0]; const float* modp = (const float*)(ws + WS_MODP); const float* bada = a.in[3]; const float* g = a.in[4];
    f16* h = (f16*)(ws + WS_H);
    LAS float* A1 = (LAS float*)lds; LAS float* B1 = A1 + DM;
    int curb = -1;
    { float* modf = (float*)(ws + WS_MODF); const int per = (2 * 6 * DM + G - 1) / G;
      for (int e = tid; e < per; e += NWAVES * 64) { const int idx = vcu * per + e; if (idx < 2 * 6 * DM) { const int b = idx / (6 * DM), j = idx % (6 * DM); float sacc = bada[j];
          for (int kc = 0; kc < 32; ++kc) sacc += modp[(size_t)(kc * 2 + b) * (6 * DM) + j]; modf[idx] = sacc; } } }
    for (int rg = vcu; rg < MTOK / 32; rg += G) {
        const int b = rg >> 7;
        if (b != curb) { __syncthreads(); curb = b; const int j = tid * 4;
            const f32x4 sh = mod4(modp, bada, b, 0 * DM + j), sc = mod4(modp, bada, b, 1 * DM + j), gg = *(const f32x4*)(g + j);
            *(LAS f32x4*)(A1 + j) = gg * (1.0f + sc); *(LAS f32x4*)(B1 + j) = sh; __syncthreads(); }
        f32x4 v[8], vn[8];
        { const f32x4* xr = (const f32x4*)(x + (size_t)(rg * 32 + wave * 4) * DM) + lane;
#pragma unroll
          for (int j = 0; j < 8; ++j) v[j] = __builtin_nontemporal_load(xr + 64 * j); }
#pragma unroll
        for (int rr = 0; rr < 4; ++rr) { const int row = rg * 32 + wave * 4 + rr;
            if (rr < 3) { const f32x4* xr = (const f32x4*)(x + (size_t)(row + 1) * DM) + lane;
#pragma unroll
                for (int j = 0; j < 8; ++j) vn[j] = __builtin_nontemporal_load(xr + 64 * j); }
            float ss = 0.f;
#pragma unroll
            for (int j = 0; j < 8; ++j) ss += (v[j][0] * v[j][0] + v[j][1] * v[j][1]) + (v[j][2] * v[j][2] + v[j][3] * v[j][3]);
            const float rstd = 1.0f / sqrtf(wave_sum(ss) * (1.0f / DM) + RMS_EPS);
            u32x2* o8 = (u32x2*)(h + (size_t)row * DM) + lane; unsigned* o4 = (unsigned*)((unsigned char*)(ws + WS_H8) + (size_t)row * DM) + lane;
#pragma unroll
            for (int j = 0; j < 8; ++j) { const int c = 4 * lane + 256 * j; const f32x4 aa = *(LAS f32x4*)(A1 + c), bb = *(LAS f32x4*)(B1 + c); const f32x4 r = v[j] * rstd * aa + bb;
                u32x2 w; w.x = pkh(r[0], r[1]); w.y = pkh(r[2], r[3]); o8[64 * j] = w;
                int w8 = 0; w8 = __builtin_amdgcn_cvt_pk_fp8_f32(r[0], r[1], w8, false); w8 = __builtin_amdgcn_cvt_pk_fp8_f32(r[2], r[3], w8, true); o4[64 * j] = (unsigned)w8; }
#pragma unroll
            for (int j = 0; j < 8; ++j) v[j] = vn[j]; }
    }
}
__device__ __forceinline__ void p7_mid(const Args& a, LAS unsigned char* lds, int vcu, int G, int wave, int lane, int tid) {
    unsigned char* ws = (unsigned char*)ldptr(lds, 6); const float* x = ldptr(lds, 0); const float* modp = (const float*)(ws + WS_MODP); const float* bada = ldptr(lds, 1);
    const float* gpost = ldptr(lds, 2); const float* gpre = ldptr(lds, 3);
    const f16* z = (const f16*)(ws + WS_QKV + 32 * MiB); const float* ssp = (const float*)(ws + WS_SSP1); f16* h2 = (f16*)(ws + WS_H); f16* x1o = (f16*)(ws + WS_WIN);
    LAS float* G1 = (LAS float*)lds; LAS float* A2 = G1 + DM; LAS float* B2 = A2 + DM;
    int curb = -1;
    for (int rg = vcu; rg < MTOK / 32; rg += G) {
        const int b = rg >> 7;
        if (b != curb) { __syncthreads(); curb = b; const int j = tid * 4;
            const float* modf = (const float*)(ws + WS_MODF) + (size_t)b * (6 * DM);
            const f32x4 gt1 = *(const f32x4*)(modf + 2 * DM + j), sh2 = *(const f32x4*)(modf + 3 * DM + j), sc2 = *(const f32x4*)(modf + 4 * DM + j);
            *(LAS f32x4*)(G1 + j) = gt1 * *(const f32x4*)(gpost + j); *(LAS f32x4*)(A2 + j) = *(const f32x4*)(gpre + j) * (1.0f + sc2); *(LAS f32x4*)(B2 + j) = sh2; __syncthreads(); }
        f32x4 xv[8], xn[8]; u32x2 zv[8], zn[8]; float spv, spn = 0.f;
        { const int row = rg * 32 + wave * 4; const f32x4* xr = (const f32x4*)(x + (size_t)row * DM) + lane; const u32x2* zr = (const u32x2*)(z + (size_t)row * DM) + lane;
          spv = lane < 32 ? ssp[(size_t)row * 32 + lane] : 0.f;
#pragma unroll
          for (int j = 0; j < 8; ++j) { xv[j] = __builtin_nontemporal_load(xr + 64 * j); zv[j] = __builtin_nontemporal_load(zr + 64 * j); } }
#pragma unroll
        for (int rr = 0; rr < 4; ++rr) { const int row = rg * 32 + wave * 4 + rr;
            if (rr < 3) { const f32x4* xr = (const f32x4*)(x + (size_t)(row + 1) * DM) + lane; const u32x2* zr = (const u32x2*)(z + (size_t)(row + 1) * DM) + lane;
                spn = lane < 32 ? ssp[(size_t)(row + 1) * 32 + lane] : 0.f;
#pragma unroll
                for (int j = 0; j < 8; ++j) { xn[j] = __builtin_nontemporal_load(xr + 64 * j); zn[j] = __builtin_nontemporal_load(zr + 64 * j); } }
            const float rstd1 = 1.0f / sqrtf(wave_sum(spv) * (1.0f / DM) + RMS_EPS);
            u32x2* xo = (u32x2*)(x1o + (size_t)row * DM) + lane;
            f32x4 v[8]; float ss = 0.f;
#pragma unroll
            for (int j = 0; j < 8; ++j) { const int c = 4 * lane + 256 * j; const f32x2 z0 = unpkh(zv[j].x), z1 = unpkh(zv[j].y); const f32x4 zz = {z0.x, z0.y, z1.x, z1.y};
                v[j] = xv[j] + *(LAS f32x4*)(G1 + c) * zz * rstd1; { u32x2 xw; xw.x = pkh(v[j][0], v[j][1]); xw.y = pkh(v[j][2], v[j][3]); xo[64 * j] = xw; }
                ss += (v[j][0] * v[j][0] + v[j][1] * v[j][1]) + (v[j][2] * v[j][2] + v[j][3] * v[j][3]); }
            const float rstd2 = 1.0f / sqrtf(wave_sum(ss) * (1.0f / DM) + RMS_EPS);
            u32x2* o8 = (u32x2*)(h2 + (size_t)row * DM) + lane;
#pragma unroll
            for (int j = 0; j < 8; ++j) { const int c = 4 * lane + 256 * j; const f32x4 r = v[j] * rstd2 * *(LAS f32x4*)(A2 + c) + *(LAS f32x4*)(B2 + c);
                u32x2 w; w.x = pkh(r[0], r[1]); w.y = pkh(r[2], r[3]); o8[64 * j] = w; }
#pragma unroll
            for (int j = 0; j < 8; ++j) { xv[j] = xn[j]; zv[j] = zn[j]; }
            spv = spn; }
    }
}
__device__ __forceinline__ void p10_final(const Args& a, LAS unsigned char* lds, int vcu, int G, int wave, int lane, int tid) {
    unsigned char* ws = (unsigned char*)ldptr(lds, 6); const float* modp = (const float*)(ws + WS_MODP); const float* bada = ldptr(lds, 1); const float* gpost = ldptr(lds, 4);
    const f16* f = (const f16*)(ws + WS_F); const float* ssp = (const float*)(ws + WS_SSP2); float* out = (float*)ldptr(lds, 5); const f16* x1h = (const f16*)(ws + WS_WIN);
    LAS float* G2 = (LAS float*)lds;
    int curb = -1;
    for (int rg = vcu; rg < MTOK / 32; rg += G) {
        const int b = rg >> 7;
        if (b != curb) { __syncthreads(); curb = b; const int j = tid * 4;
            const f32x4 gt2 = *(const f32x4*)((const float*)(ws + WS_MODF) + (size_t)b * (6 * DM) + 5 * DM + j); *(LAS f32x4*)(G2 + j) = gt2 * *(const f32x4*)(gpost + j); __syncthreads(); }
        u32x2 fv[8], fn[8], xv[8], xn[8]; float spv, spn = 0.f;
        { const int row = rg * 32 + wave * 4; const u32x2* fr = (const u32x2*)(f + (size_t)row * DM) + lane; const u32x2* xr = (const u32x2*)(x1h + (size_t)row * DM) + lane;
          spv = lane < 32 ? ssp[(size_t)row * 32 + lane] : 0.f;
#pragma unroll
          for (int j = 0; j < 8; ++j) { fv[j] = __builtin_nontemporal_load(fr + 64 * j); xv[j] = __builtin_nontemporal_load(xr + 64 * j); } }
#pragma unroll
        for (int rr = 0; rr < 4; ++rr) { const int row = rg * 32 + wave * 4 + rr;
            if (rr < 3) { const u32x2* fr = (const u32x2*)(f + (size_t)(row + 1) * DM) + lane; const u32x2* xr = (const u32x2*)(x1h + (size_t)(row + 1) * DM) + lane;
                spn = lane < 32 ? ssp[(size_t)(row + 1) * 32 + lane] : 0.f;
#pragma unroll
                for (int j = 0; j < 8; ++j) { fn[j] = __builtin_nontemporal_load(fr + 64 * j); xn[j] = __builtin_nontemporal_load(xr + 64 * j); } }
            const float rstd = 1.0f / sqrtf(wave_sum(spv) * (1.0f / DM) + RMS_EPS);
            f32x4* xo = (f32x4*)(out + (size_t)row * DM) + lane;
#pragma unroll
            for (int j = 0; j < 8; ++j) { const int c = 4 * lane + 256 * j; const f32x2 f0 = unpkh(fv[j].x), f1 = unpkh(fv[j].y); const f32x4 ff = {f0.x, f0.y, f1.x, f1.y};
                const f32x2 x0 = unpkh(xv[j].x), x1v = unpkh(xv[j].y); const f32x4 xx = {x0.x, x0.y, x1v.x, x1v.y};
                __builtin_nontemporal_store(xx + *(LAS f32x4*)(G2 + c) * ff * rstd, xo + 64 * j); }
#pragma unroll
            for (int j = 0; j < 8; ++j) { fv[j] = fn[j]; xv[j] = xn[j]; }
            spv = spn; }
    }
}

__device__ __forceinline__ unsigned fkey(float f) { const unsigned u = __float_as_uint(f); return (u & 0x80000000u) ? ~u : (u | 0x80000000u); }
#define SEL_BODY(NC_)         { \
            const int t = t0 + wave; LAS unsigned* row = sc + wave * SEQ; \
            float v[NC_]; \
_Pragma("unroll") \
            for (int i = 0; i < NC_; ++i) v[i] = __uint_as_float(row[i * 64 + lane]); \
            float thr = -__builtin_inff(); \
            if (t + 1 > DSA_TOPK) { \
                float mx = -__builtin_inff(), mn = __builtin_inff(); \
_Pragma("unroll") \
                for (int i = 0; i < NC_; ++i) { asm("v_max_f32 %0, %0, %1" : "+v"(mx) : "v"(v[i])); asm("v_min_f32 %0, %0, %1" : "+v"(mn) : "v"(v[i])); } \
_Pragma("unroll") \
                for (int o = 1; o < 64; o <<= 1) { mx = __builtin_fmaxf(mx, __shfl_xor(mx, o)); mn = __builtin_fminf(mn, __shfl_xor(mn, o)); } \
                const float scale = (mx > mn) ? 4094.5f / (mx - mn) : 0.f, off = -mn * scale; \
                LDS_WAIT(); \
_Pragma("unroll") \
                for (int i = 0; i < 16; ++i) *(LAS u32x4*)(row + (i * 64 + lane) * 4) = (u32x4){0u, 0u, 0u, 0u}; \
                LDS_WAIT(); \
_Pragma("unroll") \
                for (int i = 0; i < NC_; ++i) { \
                    const unsigned bb = (v[i] == v[i]) ? (unsigned)(int)__builtin_fmaf(v[i], scale, off) : (unsigned)lane; \
                    __hip_atomic_fetch_add(row + bb, 1u, __ATOMIC_RELAXED, __HIP_MEMORY_SCOPE_WORKGROUP); \
                    if ((i & 7) == 7) __builtin_amdgcn_sched_barrier(0); } \
                __hip_atomic_fetch_sub(row + lane, (unsigned)(NC_ - 1 - ((t - lane) >> 6)), __ATOMIC_RELAXED, __HIP_MEMORY_SCOPE_WORKGROUP); \
                LDS_WAIT(); \
                unsigned qs[16], S = 0; \
_Pragma("unroll") \
                for (int i = 0; i < 16; ++i) { const u32x4 h4 = *(const LAS u32x4*)(row + lane * 64 + i * 4); qs[i] = (h4.x + h4.y) + (h4.z + h4.w); S += qs[i]; if ((i & 3) == 3) __builtin_amdgcn_sched_barrier(0); } \
                unsigned suf = S; \
_Pragma("unroll") \
                for (int o = 1; o < 64; o <<= 1) { const unsigned y = __shfl_down(suf, o); suf += (lane + o < 64) ? y : 0u; } \
                const unsigned above = suf - S; \
                unsigned run = above; int qB = 0; unsigned runq = above; bool found = false; \
_Pragma("unroll") \
                for (int qd = 15; qd >= 0; --qd) { const bool hit = !found && (run + qs[qd] >= (unsigned)DSA_TOPK); if (hit) { qB = qd; runq = run; found = true; } run += qs[qd]; } \
                unsigned jB = 0, cabv = 0; \
                { const u32x4 h4 = *(const LAS u32x4*)(row + lane * 64 + qB * 4); unsigned r2 = runq; bool f2 = false; \
_Pragma("unroll") \
                  for (int e = 3; e >= 0; --e) { const bool hit = !f2 && (r2 + h4[e] >= (unsigned)DSA_TOPK); if (hit) { jB = (unsigned)(qB * 4 + e); cabv = r2; f2 = true; } r2 += h4[e]; } } \
                const u64 crossing = __ballot(above < (unsigned)DSA_TOPK && suf >= (unsigned)DSA_TOPK); \
                const int L = (int)__builtin_ctzll(crossing); \
                const unsigned B = (unsigned)__builtin_amdgcn_readlane((int)(jB + 64u * lane), L), cab = (unsigned)__builtin_amdgcn_readlane((int)cabv, L); \
                const int need = DSA_TOPK - (int)cab; \
                LDS_WAIT(); \
                const float blo = B ? (float)B : -__builtin_inff(), bhi = (float)(B + 1); \
                int occ = 0; \
_Pragma("unroll") \
                for (int i = 0; i < NC_; ++i) { float vi = v[i]; asm volatile("" : "+v"(vi)); \
                    const float x = __builtin_fmaf(vi, scale, off); const bool c = (x >= blo) && (x < bhi); \
                    const u64 m = __ballot(c); \
                    if (m) { const int pos = occ + (int)__builtin_popcountll(m & ((1ull << lane) - 1ull)); if (c && pos < 64) row[pos] = __float_as_uint(vi); occ += (int)__builtin_popcountll(m); } \
                    __builtin_amdgcn_sched_barrier(0); } \
                LDS_WAIT(); \
                if (occ <= 64) { \
                    const float cl = (lane < occ) ? __uint_as_float(row[lane]) : -__builtin_inff(); int gt = 0, ge = 0; \
                    for (int j = 0; j < occ; ++j) { const float x = __uint_as_float(row[j]); gt += (x > cl) ? 1 : 0; ge += (x >= cl) ? 1 : 0; } \
                    const u64 hitm = __ballot(lane < occ && gt < need && need <= ge); \
                    thr = __uint_as_float((unsigned)__builtin_amdgcn_readlane((int)__float_as_uint(cl), (int)__builtin_ctzll(hitm))); \
                } else { \
                    unsigned tk = 0u; \
                    for (int bit = 31; bit >= 0; --bit) { const unsigned cand = tk | (1u << bit); unsigned cl = 0; \
_Pragma("unroll") \
                        for (int i = 0; i < NC_; ++i) { float vi = v[i]; asm volatile("" : "+v"(vi)); cl += (vi == vi && fkey(vi) >= cand) ? 1u : 0u; } \
                        int cnt = 0; \
_Pragma("unroll") \
                        for (int bb = 0; bb < 7; ++bb) cnt += (int)__builtin_popcountll(__ballot((cl >> bb) & 1u)) << bb; \
                        if (cnt >= DSA_TOPK) tk = cand; } \
                    const unsigned ub = (tk & 0x80000000u) ? (tk ^ 0x80000000u) : ~tk; thr = __uint_as_float(ub); \
                } \
            } \
            int mlo = 0, mhi = 0; \
_Pragma("unroll") \
            for (int g4 = 0; g4 < NC_ / 4; ++g4) { const u64 m0 = __ballot(v[4 * g4] >= thr), m1 = __ballot(v[4 * g4 + 1] >= thr), m2 = __ballot(v[4 * g4 + 2] >= thr), m3 = __ballot(v[4 * g4 + 3] >= thr); \
                asm volatile("s_nop 1\n\tv_writelane_b32 %0, %2, %10\n\tv_writelane_b32 %1, %3, %10\n\tv_writelane_b32 %0, %4, %11\n\tv_writelane_b32 %1, %5, %11\n\t" \
                             "v_writelane_b32 %0, %6, %12\n\tv_writelane_b32 %1, %7, %12\n\tv_writelane_b32 %0, %8, %13\n\tv_writelane_b32 %1, %9, %13" \
                             : "+v"(mlo), "+v"(mhi) : "s"((unsigned)m0), "s"((unsigned)(m0 >> 32)), "s"((unsigned)m1), "s"((unsigned)(m1 >> 32)), "s"((unsigned)m2), "s"((unsigned)(m2 >> 32)), \
                               "s"((unsigned)m3), "s"((unsigned)(m3 >> 32)), "n"(4 * g4), "n"(4 * g4 + 1), "n"(4 * g4 + 2), "n"(4 * g4 + 3)); } \
            mask[(size_t)(tok0 + wave) * 64 + lane] = ((u64)(unsigned)mhi << 32) | (unsigned)mlo; \
        }
__device__ __forceinline__ void p3_indexer(const Args& a, LAS unsigned char* lds, int vcu, int G, int wave, int lane, int tid) {
    unsigned char* ws = a.ws;
    {
        const f16* Ka = (const f16*)(ws + WS_QKV) + 1 * QKV_ONE; float* km = (float*)(ws + WS_KMEAN);
        LAS float* red = (LAS float*)lds;
        for (int it = vcu; it < BATCH * NH * (MOBA_NB - 1); it += G) {
            const int n = it % (MOBA_NB - 1), bh = it / (MOBA_NB - 1), rg = tid >> 4, cc = tid & 15;
            const f16* p = Ka + ((size_t)bh * SEQ + n * MOBA_BLOCK + rg) * HD + cc * 8;
            f16x8 v[8];
#pragma unroll
            for (int r = 0; r < 8; ++r) v[r] = *(const f16x8*)(p + (size_t)r * 32 * HD);
            float acc[8];
#pragma unroll
            for (int e = 0; e < 8; ++e) { acc[e] = 0.f;
#pragma unroll
                for (int r = 0; r < 8; ++r) acc[e] += (float)v[r][e]; }
            __syncthreads();
#pragma unroll
            for (int e = 0; e < 8; ++e) red[rg * 128 + cc * 8 + e] = acc[e];
            __syncthreads();
            if (tid < 128) { float sum = 0.f;
#pragma unroll
                for (int r = 0; r < 32; ++r) sum += red[r * 128 + tid];
                const int b = bh / NH, hh = bh % NH;
                km[((size_t)(b * MOBA_NB + n) * NH + hh) * HD + tid] = sum * (1.0f / MOBA_BLOCK); }
        }
        __syncthreads();
    }
    const f16* qidx = (const f16*)(ws + WS_QIDX); const f16* kidx = (const f16*)(ws + WS_KIDX); const float* widx = (const float*)(ws + WS_WIDX); u64* mask = (u64*)(ws + WS_MASK);
    LAS unsigned* sc = (LAS unsigned*)lds;
    const int r32 = lane & 31, hi = lane >> 5;
    f16x8 qa[4][4]; f16x8 kA[4], kB[4]; float wnext = 0.f;
    LAS float* wl = (LAS float*)(lds + 131072);
#define IDX_DECODE(uu_, b_, t0_, ntile_) const int kq_ = (uu_) >> 8, cq_ = (uu_) & 255; b_ = (kq_ >> 1) & 1; t0_ = ((kq_ & 1) ? 511 - cq_ : cq_) * 8; ntile_ = ((t0_ + 8 + 63) >> 6) << 1
#define IDX_LOAD_UNIT(uu_) do { int b_, t0_, nt_; IDX_DECODE(uu_, b_, t0_, nt_); const int tok0_ = b_ * SEQ + t0_; int r32 = lane & 31, hi = lane >> 5; asm volatile("" : "+v"(r32), "+v"(hi));                                       \
        _Pragma("unroll") for (int mt = 0; mt < 4; ++mt) { const int tok = tok0_ + 2 * mt + (r32 >> 4), head = r32 & 15;                               \
            _Pragma("unroll") for (int ks = 0; ks < 4; ++ks) qa[mt][ks] = *(const f16x8*)(qidx + (size_t)tok * (IDXH * IDXD) + head * IDXD + ks * 16 + hi * 8); } \
        if (tid < 128) wnext = widx[(size_t)tok0_ * IDXH + tid];                                                                                       \
        const f16* kb_ = kidx + (size_t)(b_ * SEQ + r32) * IDXD + hi * 8;                                                                              \
        if (wave < nt_) { _Pragma("unroll") for (int ks = 0; ks < 4; ++ks) kA[ks] = *(const f16x8*)(kb_ + (size_t)wave * 32 * IDXD + ks * 16); }       \
        if (wave + NWAVES < nt_) { _Pragma("unroll") for (int ks = 0; ks < 4; ++ks) kB[ks] = *(const f16x8*)(kb_ + (size_t)(wave + NWAVES) * 32 * IDXD + ks * 16); } } while (0)
#define RELU_(x) __builtin_amdgcn_fmed3f((x), 0.f, 3.0e38f)
#define IDX_TILE(KF, j_) do {                                                                                                                          \
        unsigned wa_ = (unsigned)(size_t)(wl + 4 * hi), sa_ = (unsigned)(size_t)(sc + hi * SEQ + (j_) * 32 + r32); asm volatile("" : "+v"(wa_), "+v"(sa_));     \
        const bool edge_ = (j_) * 32 + 31 > t0;                                                                                                         \
        _Pragma("unroll") for (int mt = 0; mt < 4; ++mt) { f32x16 c = {};                                                                              \
            const LAS f32x4* wp_ = (const LAS f32x4*)(size_t)wa_;                                                                                      \
            const f32x4 wa0 = wp_[(2 * mt) * 4], wa1 = wp_[(2 * mt) * 4 + 2], wb0 = wp_[(2 * mt + 1) * 4], wb1 = wp_[(2 * mt + 1) * 4 + 2];            \
            _Pragma("unroll") for (int ks = 0; ks < 4; ++ks) c = __builtin_amdgcn_mfma_f32_32x32x16_f16(qa[mt][ks], KF[ks], c, 0, 0, 0);               \
            float s0 = 0.f, s1 = 0.f;                                                                                                                  \
            _Pragma("unroll") for (int r = 0; r < 4; ++r) { s0 = fmaf(wa0[r], RELU_(c[r]), s0); s0 = fmaf(wa1[r], RELU_(c[4 + r]), s0);                 \
                                                          s1 = fmaf(wb0[r], RELU_(c[8 + r]), s1); s1 = fmaf(wb1[r], RELU_(c[12 + r]), s1); }            \
            auto rr = __builtin_amdgcn_permlane32_swap(__float_as_uint(s0), __float_as_uint(s1), false, false);                                        \
            unsigned sv = __float_as_uint(__uint_as_float(rr[0]) + __uint_as_float(rr[1]));     \
            if (edge_) sv = ((j_) * 32 + r32 <= t0 + 2 * mt + hi) ? sv : 0x7FC00000u;                                                                  \
            ((LAS unsigned*)(size_t)(sa_ + (mt >> 1) * 65536))[(mt & 1) * 2 * SEQ] = sv; } } while (0)
    if (vcu < 2 * 512) { IDX_LOAD_UNIT(vcu); if (tid < 128) wl[tid] = wnext; }
    __syncthreads();
    for (int uu = vcu; uu < 2 * 512; uu += G) {
        int b, t0, ntile; IDX_DECODE(uu, b, t0, ntile); const int tok0 = b * SEQ + t0;
        int r32o = r32, hio = hi; asm volatile("" : "+v"(r32o), "+v"(hio));
        const f16* kbase = kidx + (size_t)(b * SEQ + r32o) * IDXD + hio * 8;
        for (int q = 0; q < 8; ++q) for (int c4 = ntile * 8 + tid; c4 < SEQ / 4; c4 += NWAVES * 64) *(LAS u32x4*)(sc + q * SEQ + c4 * 4) = (u32x4){0x7FC00000u, 0x7FC00000u, 0x7FC00000u, 0x7FC00000u};
        {
        for (int j = wave; j < ntile; j += 2 * NWAVES) {
            f16x8 k0[4], k1[4];
#pragma unroll
            for (int ks = 0; ks < 4; ++ks) { k0[ks] = kA[ks]; k1[ks] = kB[ks]; }
            if (j + 2 * NWAVES < ntile) {
#pragma unroll
                for (int ks = 0; ks < 4; ++ks) kA[ks] = *(const f16x8*)(kbase + (size_t)(j + 2 * NWAVES) * 32 * IDXD + ks * 16);
            }
            if (j + 3 * NWAVES < ntile) {
#pragma unroll
                for (int ks = 0; ks < 4; ++ks) kB[ks] = *(const f16x8*)(kbase + (size_t)(j + 3 * NWAVES) * 32 * IDXD + ks * 16);
            }
            IDX_TILE(k0, j);
            if (j + NWAVES < ntile) IDX_TILE(k1, j + NWAVES);
        } }
        __syncthreads();
        if (uu + G < 2 * 512) { IDX_LOAD_UNIT(uu + G); }
        switch ((t0 + wave) >> 10) { case 0: SEL_BODY(16) break; case 1: SEL_BODY(32) break; case 2: SEL_BODY(48) break; default: SEL_BODY(64) break; }
        if (tid < 128) wl[tid] = wnext;
        __syncthreads();
    }
}
#undef SEL_BODY
#undef IDX_DECODE
#undef IDX_LOAD_UNIT
#undef IDX_TILE
#undef RELU_

__device__ __forceinline__ void moba_select(const f16* Q, const float* km_bh  , int qb, LAS unsigned* selm, LAS float* kml, int tid) {
    for (int i = tid; i < 15 * HD; i += NWAVES * 64) { const int n = i >> 7, d = i & 127; kml[i] = (n < qb) ? km_bh[(size_t)n * NH * HD + d] : 0.f; }
    __syncthreads();
    const int q = tid >> 1, half = tid & 1;
    float gsc[15];
#pragma unroll
    for (int n = 0; n < 15; ++n) gsc[n] = 0.f;
    const f16* qp = Q + (size_t)q * HD + half * 64;
#pragma unroll
    for (int c = 0; c < 8; ++c) { const f16x8 qv = *(const f16x8*)(qp + c * 8);
#pragma unroll
        for (int n = 0; n < 15; ++n) { const LAS f32x4* kp = (const LAS f32x4*)(kml + n * HD + half * 64 + c * 8); const f32x4 k0 = kp[0], k1 = kp[1];
#pragma unroll
            for (int e = 0; e < 4; ++e) { gsc[n] = fmaf((float)qv[e], k0[e], gsc[n]); gsc[n] = fmaf((float)qv[4 + e], k1[e], gsc[n]); } } }
    unsigned m = 0;
#pragma unroll
    for (int n = 0; n < 15; ++n) gsc[n] += __shfl_xor(gsc[n], 1);
#pragma unroll
    for (int pass = 0; pass < MOBA_TOPK; ++pass) { float best = -__builtin_inff(); int bi = -1;
#pragma unroll
        for (int n = 0; n < 15; ++n) { const bool ok = (n < qb) && !((m >> n) & 1u) && (gsc[n] > best); if (ok) { best = gsc[n]; bi = n; } }
        if (bi >= 0) m |= 1u << bi; }
    if (half == 0) selm[q] = m;
    __syncthreads();
}
__device__ __forceinline__ void p4_attention(const Args& a, LAS unsigned char* ldsl, char* lds, int vcu, int G, int tid) {
    unsigned char* ws = a.ws;
    const f16* qkv = (const f16*)(ws + WS_QKV); f16* Obase = (f16*)(ws + WS_H); const u64* mask = (const u64*)(ws + WS_MASK); const float* km = (const float*)(ws + WS_KMEAN);
    LAS unsigned* selm = (LAS unsigned*)(ldsl + att::LDS_SELM); LAS float* kml = (LAS float*)(ldsl + att::LDS_KM);
    unsigned* ctr = (unsigned*)(ws + WS_CTL) + CW_QUEUE; LAS int* nxt = (LAS int*)(ldsl + LDSCTL_OFF + 64);
    for (;;) {
        __syncthreads();
        if (tid == 0) *nxt = (int)__hip_atomic_fetch_add(ctr, 1u, RLX_AGENT);
        __syncthreads();
        const int j = *nxt; if (j >= 512) break;
        const int qb = 15 - (j >> 5), kind = ((j >> 4) & 1) ^ 1, bh = j & 15, b = bh >> 3, h = bh & 7;
        const size_t hoff = (size_t)(b * NH + h) * SEQ * HD;
        const f16* Q = qkv + (size_t)(kind * 3 + 0) * QKV_ONE + hoff; const f16* K = qkv + (size_t)(kind * 3 + 1) * QKV_ONE + hoff; const f16* V = qkv + (size_t)(kind * 3 + 2) * QKV_ONE + hoff;
        f16* O = Obase + (size_t)kind * QKV_ONE + (size_t)b * SEQ * AW + h * HD;
        att::BlockRef r;
        r.Q = Q + (size_t)qb * 256 * HD; r.K = K; r.V = V; r.O = O + (size_t)qb * 256 * AW; r.P0 = qb * 256; r.M = mask + ((size_t)b * SEQ + qb * 256) * 64; r.sel = (const unsigned*)(lds + att::LDS_SELM);
        if (kind == 0) { moba_select(r.Q, km + ((size_t)(b * MOBA_NB) * NH + h) * HD, qb, selm, kml, tid); att::attn_block<0, true>(r, lds); }
        else { att::attn_block<1, true>(r, lds); }
    }
    asm volatile("s_waitcnt vmcnt(0)" ::: "memory"); __syncthreads();
}

__global__ void __launch_bounds__(NWAVES * 64, 2) mk_fwd(Args args) {
    extern __shared__ __attribute__((aligned(16))) unsigned char lds[];
    LAS unsigned char* ldsl = (LAS unsigned char*)lds;
    volatile LAS unsigned* MISC = (volatile LAS unsigned*)(ldsl + MISC_OFF);
    const int tid = threadIdx.x, lane = tid & 63, wave = __builtin_amdgcn_readfirstlane(tid >> 6);
    const int G = gridDim.x; int vcu; { const int bx = blockIdx.x; vcu = (G % 8 == 0) ? (bx % 8) * (G / 8) + bx / 8 : bx; }
    unsigned char* ws = args.ws;
    gu32* ctl = (gu32*)(ws + WS_CTL);
    for (int u = tid; u < (LDS_BYTES - LDSCTL_OFF) / 4; u += NWAVES * 64) ((LAS unsigned*)(ldsl + LDSCTL_OFF))[u] = 0u;
    __syncthreads();
    if (tid == 0) { LAS u64* pt = (LAS u64*)(ldsl + PTRTAB_OFF);
        pt[0] = (u64)args.in[0]; pt[1] = (u64)args.in[3]; pt[2] = (u64)args.in[5]; pt[3] = (u64)args.in[10]; pt[4] = (u64)args.in[11]; pt[5] = (u64)args.out; pt[6] = (u64)args.ws;
        pt[7] = (u64)args.in[6]; pt[8] = (u64)args.in[7]; pt[9] = (u64)args.in[8]; pt[10] = (u64)args.in[9]; pt[11] = (u64)args.in[12]; pt[12] = (u64)args.in[13]; }
    __syncthreads();
    XcdBarrier bar; bar.bar = (unsigned*)(ctl + CW_BAR); bar.x = 0; bar.st = nullptr;
    if (MK_N_LAUNCHES == 1) bar = xcd_barrier_post((unsigned*)(ctl + CW_BAR), MISC + 8);
    const int lo = args.ph_lo, hi = args.ph_hi;
#define IN(k) (lo <= (k) && (k) < hi)
#define SEAM(k) do { if (IN(k) && IN((k) + 1)) xcd_barrier(bar); } while (0)
    if (IN(0)) { p0_prologue(args, ldsl, vcu, G, wave, lane, tid); } SEAM(0);
    if (IN(1)) { p1_norm_in(args, ldsl, vcu, G, wave, lane, tid); } SEAM(1);
    if (IN(2)) {
        { pg8::Gemm g{(const f16*)(ws + WS_H), (const f16*)(ws + WS_WIN), nullptr, nullptr, DM};
          pg8::StaticOrder S; S.init(MTOK, N_IN16, G, (int)blockIdx.x);
          pg8::EpiIn E{(f16*)(ws + WS_QKV), (f16*)(ws + WS_QIDX), (f16*)(ws + WS_KIDX), (float*)(ws + WS_WIDX), (f16*)(ws + WS_GA), (f16*)(ws + WS_GB), (const float*)(ws + WS_ROPEA), (const float*)(ws + WS_ROPEB), 0};
          pg8::gemm_phase<pg8::EpiIn, pg8::StaticOrder, true>(ldsl, g, S, E); }
        { pg8::Gemm g{(const f16*)(ws + WS_H8), (const f16*)(ws + WS_WG8), nullptr, nullptr, DM};
          pg8::StaticOrder S; S.init(MTOK, N_IN8, G, (int)blockIdx.x);
          pg8::EpiIn E{(f16*)(ws + WS_QKV), (f16*)(ws + WS_QIDX), (f16*)(ws + WS_KIDX), (float*)(ws + WS_WIDX), (f16*)(ws + WS_GA), (f16*)(ws + WS_GB), (const float*)(ws + WS_ROPEA), (const float*)(ws + WS_ROPEB), 1};
          pg8::gemm_phase<pg8::EpiIn, pg8::StaticOrder, true, true, 0x7F7F7F7F, 0x77777777, true>(ldsl, g, S, E); }
        if (CONV_SPLIT < CONV_TOTAL) {
            const int rem = ((MTOK / 256) * (N_IN16 / 256)) % G, wi = rem ? (int)blockIdx.x - rem : (int)blockIdx.x, nw = rem ? G - rem : G;
            if (wi >= 0) conv_items(ws, ldptr(ldsl, 7), ldptr(ldsl, 8), ldptr(ldsl, 9), ldptr(ldsl, 10), ldptr(ldsl, 11), ldptr(ldsl, 12), ldsl, CONV_SPLIT, CONV_TOTAL, wi * NWAVES + wave, nw * NWAVES, wave, lane); }
    } SEAM(2);
    if (IN(3)) { p3_indexer(args, ldsl, vcu, G, wave, lane, tid); } SEAM(3);
    if (IN(4)) { p4_attention(args, ldsl, (char*)lds, vcu, G, tid); } SEAM(4);
    if (IN(5)) {
        pg8::Gemm g{(const f16*)(ws + WS_H), (const f16*)(ws + WS_WMO), (const f16*)(ws + WS_H) + QKV_ONE, (const f16*)(ws + WS_WDO), AW};
        pg8::StaticOrder S; S.init(MTOK, DM, G, (int)blockIdx.x, 2);
        pg8::EpiOut E{(const f16*)(ws + WS_GA), (const f16*)(ws + WS_GB), (unsigned char*)(ws + WS_QKV)};
        pg8::gemm_phase<pg8::EpiOut, pg8::StaticOrder, true>(ldsl, g, S, E);
    } SEAM(5);
    if (IN(6)) {
        pg8::Gemm g{(const f16*)(ws + WS_QKV), (const f16*)(ws + WS_WO), nullptr, nullptr, DM};
        pg8::StaticOrder S; S.init(MTOK, DM, G, (int)blockIdx.x);
        pg8::EpiSq E{(f16*)(ws + WS_QKV + 32 * MiB), (float*)(ws + WS_SSP1)};
        pg8::gemm_phase<pg8::EpiSq, pg8::StaticOrder, false, true, 0x7B7B7B7B, 0x77777777, true>(ldsl, g, S, E);
    } SEAM(6);
    if (IN(7)) { int t2 = threadIdx.x; asm volatile("" : "+v"(t2)); p7_mid(args, ldsl, vcu, G, __builtin_amdgcn_readfirstlane(t2 >> 6), t2 & 63, t2); } SEAM(7);
    if (IN(8)) {
        pg8::Gemm g{(const f16*)(ws + WS_H), (const f16*)(ws + WS_W1), nullptr, nullptr, DM};
        pg8::StaticOrder S; S.init(MTOK, FF, G, (int)blockIdx.x);
        pg8::EpiRelu2 E{(unsigned char*)(ws + WS_U)};
        pg8::gemm_phase<pg8::EpiRelu2, pg8::StaticOrder, true, false, 0x7F7F7F7F, 0x7F7F7F7F, true>(ldsl, g, S, E);
    } SEAM(8);
    if (IN(9)) {
        pg8::Gemm g{(const f16*)(ws + WS_U), (const f16*)(ws + WS_W2), nullptr, nullptr, FF};
        pg8::StaticOrder S; S.init(MTOK, DM, G, (int)blockIdx.x);
        pg8::EpiSq E{(f16*)(ws + WS_F), (float*)(ws + WS_SSP2)};
        pg8::gemm_phase<pg8::EpiSq, pg8::StaticOrder, false, true, 0x7F7F7F7F, 0x77777777, true>(ldsl, g, S, E);
    } SEAM(9);
    if (IN(10)) { int t2 = threadIdx.x; asm volatile("" : "+v"(t2)); p10_final(args, ldsl, vcu, G, __builtin_amdgcn_readfirstlane(t2 >> 6), t2 & 63, t2); }
#undef IN
#undef SEAM
}

extern "C" void kernel_launch(void* const* d_in, const int* in_sizes, int n_in, void* d_out, int out_size, void* d_ws, size_t ws_size, hipStream_t stream) {
    static int grid = 0;
    if (grid == 0) {
        if (n_in != 14 || out_size != MTOK * DM || ws_size < WS_END) { fprintf(stderr, "kernel_launch: unexpected shapes (n_in %d out %d ws %zu)\n", n_in, out_size, ws_size); grid = -1; return; }
        int dev = 0, cus = 0;
        if (hipGetDevice(&dev) != hipSuccess || hipDeviceGetAttribute(&cus, hipDeviceAttributeMultiprocessorCount, dev) != hipSuccess) { grid = -1; return; }
        if (hipFuncSetAttribute((const void*)mk_fwd, hipFuncAttributeMaxDynamicSharedMemorySize, LDS_BYTES) != hipSuccess) { fprintf(stderr, "kernel_launch: hipFuncSetAttribute failed\n"); grid = -1; return; }
        int per_cu = 0;
        if (hipOccupancyMaxActiveBlocksPerMultiprocessor(&per_cu, (const void*)mk_fwd, NWAVES * 64, LDS_BYTES) != hipSuccess || per_cu < 1) { fprintf(stderr, "kernel_launch: occupancy query says %d\n", per_cu); }
        (void)hipGetLastError();
        grid = cus;
    }
    if (grid < 0) return;
    (void)hipMemsetAsync((char*)d_ws + WS_CTL, 0, CTL_ZERO_BYTES, stream);
    Args a{};
    for (int i = 0; i < 14; ++i) a.in[i] = (const float*)d_in[i];
    a.out = (float*)d_out; a.ws = (unsigned char*)d_ws;
    if (MK_N_LAUNCHES == 1) {
        a.ph_lo = 0; a.ph_hi = NPHASE;
        hipLaunchKernelGGL(mk_fwd, dim3(grid), dim3(NWAVES * 64), LDS_BYTES, stream, a);
    } else {
        for (int p = 0; p < NPHASE; ++p) { a.ph_lo = p; a.ph_hi = p + 1;
            for (int r = 0; r < (((MK_DOUBLE_MASK >> p) & 1) ? 2 : 1); ++r) hipLaunchKernelGGL(mk_fwd, dim3(grid), dim3(NWAVES * 64), LDS_BYTES, stream, a); }
    }
}
```
